# Optimizing an MI355X kernel written in HIP

```python
import jax, jax.numpy as jnp
from jax import lax
import numpy as np

D_MODEL = 1024
BATCH = 32
SEQ = 2048
DEPTH = 1

HEAD_DIM = 64
N_Q_HEADS = 8
N_KV_HEADS = 2
WINDOW = 128
ATT_BLOCK = 128
N_BUCKETS = 32
MAX_DISTANCE = 128
REC_HEADS = 4
REC_KEY_DIM = 128
REC_VAL_DIM = 128
REC_CHUNK = 64
D_FF = 2816
PLE_DIM = 256
EPS = 1e-6

ATT_Q_W = N_Q_HEADS * HEAD_DIM
ATT_KV_W = N_KV_HEADS * HEAD_DIM
REC_K_W = REC_HEADS * REC_KEY_DIM
REC_V_W = REC_HEADS * REC_VAL_DIM
IN_W = ATT_Q_W + 2 * ATT_KV_W + 2 * REC_K_W + 2 * REC_V_W + 2 * D_MODEL

kernel_name = "hybrid_swa_hgrn2_macaron_block"


def _split_points():
    widths = [ATT_Q_W, ATT_KV_W, ATT_KV_W, REC_K_W, REC_K_W, REC_V_W, REC_V_W, D_MODEL]
    return [int(v) for v in np.cumsum(widths)]


def rms_norm(x, g):
    xf = x.astype(jnp.float32)
    y = xf * lax.rsqrt(jnp.mean(xf * xf, axis=-1, keepdims=True) + EPS)
    return (y * g.astype(jnp.float32)).astype(x.dtype)


def swiglu(x, w_in, w_out):
    gate, up = jnp.split(x @ w_in, 2, axis=-1)
    return (jax.nn.silu(gate) * up) @ w_out


def t5_band_buckets():
    qi = np.arange(ATT_BLOCK)[:, None] + ATT_BLOCK
    kj = np.arange(2 * ATT_BLOCK)[None, :]
    dist = qi - kj
    n = np.maximum(dist, 0)
    max_exact = N_BUCKETS // 2
    large = max_exact + (np.log(np.maximum(n, 1) / max_exact)
                         / np.log(MAX_DISTANCE / max_exact)
                         * (N_BUCKETS - max_exact)).astype(np.int32)
    large = np.minimum(large, N_BUCKETS - 1)
    bucket = np.where(n < max_exact, n, large).astype(np.int32)
    return bucket, dist.astype(np.int32)


def sliding_window_attention(q, k, v, rel_table, sinks):
    B, S = q.shape[0], q.shape[1]
    nb = S // ATT_BLOCK
    G = N_Q_HEADS // N_KV_HEADS
    qb = q.reshape(B, nb, ATT_BLOCK, N_KV_HEADS, G, HEAD_DIM)

    def band(t):
        t = t.reshape(B, nb, ATT_BLOCK, N_KV_HEADS, HEAD_DIM)
        prev = jnp.pad(t, ((0, 0), (1, 0), (0, 0), (0, 0), (0, 0)))[:, :-1]
        return jnp.concatenate([prev, t], axis=2)

    kb, vb = band(k), band(v)
    s = jnp.einsum('bnqhgd,bnkhd->bnhgqk', qb, kb).astype(jnp.float32) * (HEAD_DIM ** -0.5)
    bucket, dist = t5_band_buckets()
    bias = rel_table.astype(jnp.float32)[bucket]
    bias = bias.transpose(2, 0, 1).reshape(N_KV_HEADS, G, ATT_BLOCK, 2 * ATT_BLOCK)
    key_pos = (jnp.arange(nb)[:, None, None] * ATT_BLOCK - ATT_BLOCK
               + jnp.arange(2 * ATT_BLOCK)[None, None, :])
    dist_j = jnp.asarray(dist)[None]
    valid = (dist_j >= 0) & (dist_j < WINDOW) & (key_pos >= 0)
    s = jnp.where(valid[None, :, None, None], s + bias, -jnp.inf)
    sink = sinks.astype(jnp.float32).reshape(N_KV_HEADS, G, 1, 1)
    m = jnp.maximum(jnp.max(s, axis=-1, keepdims=True), sink)
    e = jnp.exp(s - m)
    probs = e / (jnp.sum(e, axis=-1, keepdims=True) + jnp.exp(sink - m))
    o = jnp.einsum('bnhgqk,bnkhd->bnqhgd', probs.astype(v.dtype), vb)
    return o.reshape(B, S, ATT_Q_W)


def hgrn2_recurrence(q, f_logit, i, lb):
    B, S = q.shape[0], q.shape[1]
    nc = S // REC_CHUNK
    lbf = lb.astype(jnp.float32).reshape(REC_HEADS, REC_KEY_DIM)
    f = lbf + (1.0 - lbf) * jax.nn.sigmoid(f_logit.astype(jnp.float32))
    log_f = jnp.log(f)
    k = 1.0 - f

    def to_chunks(t):
        return t.reshape(B, nc, REC_CHUNK, REC_HEADS, t.shape[-1]).transpose(1, 0, 3, 2, 4)

    qc = to_chunks(q.astype(jnp.float32))
    kc = to_chunks(k)
    vc = to_chunks(i.astype(jnp.float32))
    gc = to_chunks(log_f)
    causal = jnp.tril(jnp.ones((REC_CHUNK, REC_CHUNK), dtype=bool))[:, :, None]

    def step(state, inp):
        qt, kt, vt, gt = inp
        b = jnp.cumsum(gt, axis=2)
        diff = b[:, :, :, None, :] - b[:, :, None, :, :]
        decay = jnp.exp(jnp.where(causal, diff, -jnp.inf))
        attn = jnp.einsum('bhtd,bhsd,bhtsd->bhts', qt, kt, decay)
        o = (jnp.einsum('bhts,bhsv->bhtv', attn, vt)
             + jnp.einsum('bhtd,bhdv->bhtv', qt * jnp.exp(b), state))
        b_last = b[:, :, -1:, :]
        new_state = (jnp.exp(b_last[:, :, 0, :])[..., None] * state
                     + jnp.einsum('bhsd,bhsv->bhdv', kt * jnp.exp(b_last - b), vt))
        return new_state, o

    s0 = jnp.zeros((B, REC_HEADS, REC_KEY_DIM, REC_VAL_DIM), jnp.float32)
    _, o = lax.scan(step, s0, (qc, kc, vc, gc))
    return o.transpose(1, 0, 3, 2, 4).reshape(B, S, REC_HEADS, REC_VAL_DIM).astype(q.dtype)


def setup_inputs(seed: int = 0) -> dict:
    key = jax.random.key(seed)
    ks = jax.random.split(key, 24)
    f32 = jnp.float32

    def nrm(k, shape, scale):
        return jax.random.normal(k, shape, f32) * scale

    def gain(k, shape):
        return 1.0 + 0.05 * jax.random.normal(k, shape, f32)

    return {
        "x": nrm(ks[0], (BATCH, SEQ, D_MODEL), 1.0),
        "p": nrm(ks[1], (DEPTH, BATCH, SEQ, PLE_DIM), 1.0),
        "rel_bias": nrm(ks[2], (N_BUCKETS, N_Q_HEADS), 0.5),
        "lb_param": nrm(ks[3], (DEPTH + 1, REC_K_W), 1.0),
        "norm_ffn1": gain(ks[4], (DEPTH, D_MODEL)),
        "w_ffn1_in": nrm(ks[5], (DEPTH, D_MODEL, 2 * D_FF), D_MODEL ** -0.5),
        "w_ffn1_out": nrm(ks[6], (DEPTH, D_FF, D_MODEL), D_FF ** -0.5),
        "norm_mix": gain(ks[7], (DEPTH, D_MODEL)),
        "w_in": nrm(ks[8], (DEPTH, D_MODEL, IN_W), D_MODEL ** -0.5),
        "attn_sinks": nrm(ks[9], (DEPTH, N_Q_HEADS), 1.0),
        "rec_norm": gain(ks[10], (DEPTH, REC_VAL_DIM)),
        "w_att_proj": nrm(ks[11], (DEPTH, ATT_Q_W, D_MODEL), ATT_Q_W ** -0.5),
        "w_rec_proj": nrm(ks[12], (DEPTH, REC_V_W, D_MODEL), REC_V_W ** -0.5),
        "w_out": nrm(ks[13], (DEPTH, D_MODEL, D_MODEL), D_MODEL ** -0.5),
        "norm_ffn2": gain(ks[14], (DEPTH, D_MODEL)),
        "w_ffn2_in": nrm(ks[15], (DEPTH, D_MODEL, 2 * D_FF), D_MODEL ** -0.5),
        "w_ffn2_out": nrm(ks[16], (DEPTH, D_FF, D_MODEL), D_FF ** -0.5),
        "norm_ple": gain(ks[17], (DEPTH, D_MODEL)),
        "w_ple_gate": nrm(ks[18], (DEPTH, D_MODEL, D_MODEL), D_MODEL ** -0.5),
        "w_ple_proj": nrm(ks[19], (DEPTH, PLE_DIM, D_MODEL), PLE_DIM ** -0.5),
        "norm_final": gain(ks[20], (D_MODEL,)),
    }


def reference(x, p, rel_bias, lb_param, norm_ffn1, w_ffn1_in, w_ffn1_out, norm_mix, w_in,
              attn_sinks, rec_norm, w_att_proj, w_rec_proj, w_out, norm_ffn2, w_ffn2_in,
              w_ffn2_out, norm_ple, w_ple_gate, w_ple_proj, norm_final):
    B, S = x.shape[0], x.shape[1]
    lower_bounds = jnp.cumsum(jax.nn.softmax(lb_param.astype(jnp.float32), axis=0), axis=0)
    splits = _split_points()
    h = x
    for layer in range(DEPTH):
        h = h + 0.5 * swiglu(rms_norm(h, norm_ffn1[layer]), w_ffn1_in[layer], w_ffn1_out[layer])

        u = rms_norm(h, norm_mix[layer])
        proj = u @ w_in[layer]
        aq, ak, av, rq, rf, ri, rg, ga, gb = jnp.split(proj, splits, axis=-1)

        att = sliding_window_attention(
            aq.reshape(B, S, N_Q_HEADS, HEAD_DIM),
            ak.reshape(B, S, N_KV_HEADS, HEAD_DIM),
            av.reshape(B, S, N_KV_HEADS, HEAD_DIM),
            rel_bias, attn_sinks[layer])

        rec = hgrn2_recurrence(
            rq.reshape(B, S, REC_HEADS, REC_KEY_DIM),
            rf.reshape(B, S, REC_HEADS, REC_KEY_DIM),
            ri.reshape(B, S, REC_HEADS, REC_VAL_DIM),
            lower_bounds[layer])
        rec = rms_norm(rec, rec_norm[layer]).reshape(B, S, REC_V_W) * jax.nn.sigmoid(rg)

        y_a = att @ w_att_proj[layer]
        y_b = rec @ w_rec_proj[layer]
        merged = jax.nn.sigmoid(ga) * y_a + jax.nn.sigmoid(gb) * y_b
        h = h + merged @ w_out[layer]

        h = h + 0.5 * swiglu(rms_norm(h, norm_ffn2[layer]), w_ffn2_in[layer], w_ffn2_out[layer])

        gate = jax.nn.sigmoid(rms_norm(h, norm_ple[layer]) @ w_ple_gate[layer])
        h = h + gate * (p[layer] @ w_ple_proj[layer])
    return rms_norm(h, norm_final)
```

```cpp
#include <hip/hip_runtime.h>
#include <hip/hip_cooperative_groups.h>
#include <cstdio>
#include <cstdint>
namespace cg = cooperative_groups;
namespace pg8 {
#define PG8_LAS __attribute__((address_space(3)))
typedef unsigned short bf16_t;
typedef short bf16x8 __attribute__((ext_vector_type(8)));
typedef float f32x4 __attribute__((ext_vector_type(4)));
typedef unsigned u32x4 __attribute__((ext_vector_type(4)));
constexpr int BM = 256, BK = 64, HALF = 128, HTB = HALF * BK * 2  , STAGE_BYTES = 8 * HTB, NXCD = 8, WGM = 8;

__host__ __device__ __forceinline__ int lds_byte(int r, int c) { const int st = (r >> 4) * 2 + (c >> 5), rr = r & 15, cc = c & 31, ob = rr * 64 + cc * 2; return st * 1024 + (ob ^ (((ob >> 9) & 1) << 5)); }
__host__ __device__ __forceinline__ void stage_rc(int b, int& R, int& C) { const int st = b / 1024, sb = b % 1024, swz = sb ^ (((sb >> 9) & 1) << 5); R = (st >> 1) * 16 + swz / 64; C = (st & 1) * 32 + (swz % 64) / 2; }
__host__ __device__ __forceinline__ int perm32(int rho) { const int n = rho >> 4, i = rho & 15; return 8 * (i >> 2) + 4 * n + (i & 3); }

struct Unit { int pm, pn; };
struct Gemm { const bf16_t* A; const bf16_t* Bt; int M, N, K; };

struct StaticOrder {
    int nM, nN, nwg, G, c;
    __host__ __device__ void init(int M, int N, int G_, int c_) { nM = M / BM; nN = N / BM; nwg = nM * nN; G = G_; c = c_; }
    __host__ __device__ bool next(int i, Unit& u) const {
        const long L = (long)i * G + c; if (L >= nwg) return false;
        int wgid = (int)L; { const int q = nwg / NXCD, r = nwg % NXCD, xcd = wgid % NXCD, off = wgid / NXCD; wgid = (xcd < r ? xcd * (q + 1) : r * (q + 1) + (xcd - r) * q) + off; }
        const int nig = WGM * nN, gid = wgid / nig, fm = gid * WGM, gsz = (nM - fm) < WGM ? (nM - fm) : WGM;
        u.pm = fm + ((wgid % nig) % gsz); u.pn = (wgid % nig) / gsz; return true;
    }
    __device__ __forceinline__ void a_ready(const Unit&) const {}
    __device__ __forceinline__ void done(const Unit&) const {}
};

__device__ __forceinline__ unsigned cvt_pk_bf16(float lo, float hi) { unsigned r; asm volatile("v_cvt_pk_bf16_f32 %0, %1, %2" : "=v"(r) : "v"(lo), "v"(hi)); return r; }
typedef float f32x2 __attribute__((ext_vector_type(2)));
__device__ __forceinline__ float sigm(float x) { return __builtin_amdgcn_rcpf(1.0f + __builtin_amdgcn_exp2f(-1.44269504f * x)); }
__device__ __forceinline__ float bflo(unsigned w) { return __uint_as_float(w << 16); }
__device__ __forceinline__ float bfhi(unsigned w) { return __uint_as_float(w & 0xffff0000u); }
constexpr float RMS_EPS = 1e-6f;

struct EpiSwiglu {
    static constexpr bool PERM = true, AFTER_DRAIN = false, ROWSTAT = true;
    bf16_t* O; const float* ss;
    __device__ __forceinline__ void operator()(const f32x4 (&acc)[2][2][4][2], const Unit& u, int wr, int wc, int fr, int fq, const PG8_LAS float* rs, PG8_LAS float* xch, int tid) const {
        const int row0 = u.pm * BM + wr * 64 + fr, col0 = u.pn * 128 + wc * 32 + 8 * fq;
        float rv[2][4];
#pragma unroll
        for (int ai = 0; ai < 2; ++ai)
#pragma unroll
            for (int m = 0; m < 4; ++m) { const f32x4 q4 = *(const PG8_LAS f32x4*)(rs + (ai * HALF + wr * 64 + m * 16 + fr) * 4); rv[ai][m] = (q4[0] + q4[1]) + (q4[2] + q4[3]); }
#pragma unroll
        for (int ai = 0; ai < 2; ++ai)
#pragma unroll
            for (int m = 0; m < 4; ++m) {
                const int row = row0 + ai * HALF + m * 16;
                const float rinv = __builtin_amdgcn_rsqf(rv[ai][m] * (1.0f / 1024.0f) + RMS_EPS);
                const float nrl = -1.44269504f * rinv, rsq2 = rinv * rinv;
                unsigned ww[4];
#pragma unroll
                for (int n = 0; n < 2; ++n) {
                    const f32x4 ag = acc[ai][0][m][n], au = acc[ai][1][m][n];
                    const f32x4 t = ag * nrl;
                    f32x4 e; e[0] = __builtin_amdgcn_exp2f(t[0]); e[1] = __builtin_amdgcn_exp2f(t[1]); e[2] = __builtin_amdgcn_exp2f(t[2]); e[3] = __builtin_amdgcn_exp2f(t[3]);
                    const f32x4 d = e + 1.0f;
                    f32x4 r; r[0] = __builtin_amdgcn_rcpf(d[0]); r[1] = __builtin_amdgcn_rcpf(d[1]); r[2] = __builtin_amdgcn_rcpf(d[2]); r[3] = __builtin_amdgcn_rcpf(d[3]);
                    const f32x4 a = (ag * au) * (r * rsq2);
                    ww[2 * n] = cvt_pk_bf16(a[0], a[1]); ww[2 * n + 1] = cvt_pk_bf16(a[2], a[3]);
                }
                u32x4 w; w.x = ww[0]; w.y = ww[1]; w.z = ww[2]; w.w = ww[3];
                *(u32x4*)(O + (size_t)row * 2816 + col0) = w;
            }
    }
};

#define UNPK8(V_, lo4, hi4) do { const u32x4 v__ = (V_); lo4 = (f32x4){bflo(v__.x), bfhi(v__.x), bflo(v__.y), bfhi(v__.y)}; hi4 = (f32x4){bflo(v__.z), bfhi(v__.z), bflo(v__.w), bfhi(v__.w)}; } while (0)
#define SUMSQ8(a, b) (((a)[0] * (a)[0] + (a)[1] * (a)[1]) + ((a)[2] * (a)[2] + (a)[3] * (a)[3]) + ((b)[0] * (b)[0] + (b)[1] * (b)[1]) + ((b)[2] * (b)[2] + (b)[3] * (b)[3]))
template <bool BASE_F32> struct EpiRes {
    static constexpr bool PERM = true, AFTER_DRAIN = false, ROWSTAT = false;
    const float* base; bf16_t* hb; float* ssout; float alpha;
    __device__ __forceinline__ void operator()(const f32x4 (&acc)[2][2][4][2], const Unit& u, int wr, int wc, int fr, int fq, const PG8_LAS float* rs, PG8_LAS float* xch, int tid) const {
        const int row0 = u.pm * BM + wr * 64 + fr, col0 = u.pn * BM + wc * 32 + 8 * fq;
        if constexpr (!BASE_F32) {
            u32x4 pw[2][4][2];
#pragma unroll
            for (int ai = 0; ai < 2; ++ai)
#pragma unroll
                for (int m = 0; m < 4; ++m)
#pragma unroll
                    for (int bj = 0; bj < 2; ++bj) pw[ai][m][bj] = *(const u32x4*)(hb + (size_t)(row0 + ai * HALF + m * 16) * 1024 + col0 + bj * HALF);
#pragma unroll
            for (int ai = 0; ai < 2; ++ai)
#pragma unroll
                for (int m = 0; m < 4; ++m) {
                    const int row = row0 + ai * HALF + m * 16; float s = 0.f;
#pragma unroll
                    for (int bj = 0; bj < 2; ++bj) {
                        const size_t off = (size_t)row * 1024 + col0 + bj * HALF;
                        f32x4 b0, b1; UNPK8(pw[ai][m][bj], b0, b1);
                        const f32x4 o0 = b0 + acc[ai][bj][m][0] * alpha, o1 = b1 + acc[ai][bj][m][1] * alpha;
                        u32x4 w; w.x = cvt_pk_bf16(o0[0], o0[1]); w.y = cvt_pk_bf16(o0[2], o0[3]); w.z = cvt_pk_bf16(o1[0], o1[1]); w.w = cvt_pk_bf16(o1[2], o1[3]);
                        *(u32x4*)(hb + off) = w;
                        s += SUMSQ8(o0, o1);
                    }
                    s += __shfl_xor(s, 16); s += __shfl_xor(s, 32);
                    if (fq == 0) xch[(row - u.pm * BM) * 4 + wc] = s;
                }
        } else {
            f32x4 pb[2][2][2][2];
#define ER_LOAD(slot, g) do { _Pragma("unroll") for (int mm = 0; mm < 2; ++mm) _Pragma("unroll") for (int bj = 0; bj < 2; ++bj) { \
                const size_t off_ = (size_t)(row0 + ((g) >> 1) * HALF + (2 * ((g) & 1) + mm) * 16) * 1024 + col0 + bj * HALF; \
                pb[slot][mm][bj][0] = *(const f32x4*)(base + off_); pb[slot][mm][bj][1] = *(const f32x4*)(base + off_ + 4); } } while (0)
            ER_LOAD(0, 0);
#pragma unroll
            for (int g = 0; g < 4; ++g) {
                if (g + 1 < 4) ER_LOAD((g + 1) & 1, g + 1);
#pragma unroll
                for (int mm = 0; mm < 2; ++mm) {
                    const int ai = g >> 1, m = 2 * (g & 1) + mm; const int row = row0 + ai * HALF + m * 16; float s = 0.f;
#pragma unroll
                    for (int bj = 0; bj < 2; ++bj) {
                        const size_t off = (size_t)row * 1024 + col0 + bj * HALF;
                        const f32x4 o0 = pb[g & 1][mm][bj][0] + acc[ai][bj][m][0] * alpha, o1 = pb[g & 1][mm][bj][1] + acc[ai][bj][m][1] * alpha;
                        u32x4 w; w.x = cvt_pk_bf16(o0[0], o0[1]); w.y = cvt_pk_bf16(o0[2], o0[3]); w.z = cvt_pk_bf16(o1[0], o1[1]); w.w = cvt_pk_bf16(o1[2], o1[3]);
                        *(u32x4*)(hb + off) = w;
                        s += SUMSQ8(o0, o1);
                    }
                    s += __shfl_xor(s, 16); s += __shfl_xor(s, 32);
                    if (fq == 0) xch[(row - u.pm * BM) * 4 + wc] = s;
                }
            }
#undef ER_LOAD
        }
        asm volatile("s_waitcnt lgkmcnt(0)\n\ts_barrier" ::: "memory");
        if (tid < BM) { const f32x4 q4 = *(const PG8_LAS f32x4*)(xch + tid * 4); ssout[((size_t)u.pm * BM + tid) * 4 + u.pn] = (q4[0] + q4[1]) + (q4[2] + q4[3]); }
    }
};

struct EpiWin {
    static constexpr bool PERM = true, AFTER_DRAIN = false, ROWSTAT = true;
    const float* ss; const float* lbp; bf16_t *Q, *Kb, *VT, *RQ, *RG, *RIT, *SG, *GA, *GB;
    __device__ __forceinline__ void operator()(const f32x4 (&acc)[2][2][4][2], const Unit& u, int wr, int wc, int fr, int fq, const PG8_LAS float* rs, PG8_LAS float* xch, int tid) const {
        const int pn = u.pn, row0 = u.pm * BM + wr * 64 + fr, cl = wc * 32 + 8 * fq;
        int kind = 0; float scale = 1.f; bf16_t* dst = Q; int pitch = 512, cbase = 0; int trw = 0;
        if (pn < 2) { dst = Q; cbase = pn * 256; scale = 0.125f; }
        else if (pn == 2) { dst = Kb; pitch = 128; cbase = 0; }
        else if (pn < 5) { dst = RQ; cbase = (pn - 3) * 256; }
        else if (pn < 7) { dst = RG; cbase = (pn - 5) * 256; kind = 1; }
        else if (pn < 9) { dst = RIT; cbase = (pn - 7) * 256; trw = 512; }
        else if (pn < 11) { dst = SG; cbase = (pn - 9) * 256; kind = 2; }
        else if (pn < 15) { dst = GA; pitch = 1024; cbase = (pn - 11) * 256; kind = 2; }
        else { dst = GB; pitch = 1024; cbase = (pn - 15) * 256; kind = 2; }
        f32x4 lb[2][2];
#pragma unroll
        for (int bj = 0; bj < 2; ++bj)
#pragma unroll
            for (int n = 0; n < 2; ++n) lb[bj][n] = (f32x4){0.f, 0.f, 0.f, 0.f};
        if (kind == 1) {
#pragma unroll
            for (int bj = 0; bj < 2; ++bj)
#pragma unroll
                for (int n = 0; n < 2; ++n) {
                    const int c = cbase + bj * HALF + cl + 4 * n;
                    const f32x4 p0 = *(const f32x4*)(lbp + c), p1 = *(const f32x4*)(lbp + 512 + c);
#pragma unroll
                    for (int j = 0; j < 4; ++j) lb[bj][n][j] = sigm(p0[j] - p1[j]);
                }
        }
        float rv[2][4];
#pragma unroll
        for (int ai = 0; ai < 2; ++ai)
#pragma unroll
            for (int m = 0; m < 4; ++m) { const f32x4 q4 = *(const PG8_LAS f32x4*)(rs + (ai * HALF + wr * 64 + m * 16 + fr) * 4); rv[ai][m] = (q4[0] + q4[1]) + (q4[2] + q4[3]); }
        PG8_LAS unsigned short* tsw = (PG8_LAS unsigned short*)xch + (wr * 4 + wc) * 1280;
#pragma unroll
        for (int ai = 0; ai < 2; ++ai)
#pragma unroll
            for (int mp = 0; mp < 2; ++mp)
#pragma unroll
                for (int bj = 0; bj < 2; ++bj) {
                    const bool tr = (trw != 0) || (pn == 2 && bj == 1);
#pragma unroll
                    for (int m2 = 0; m2 < 2; ++m2) {
                        const int m = 2 * mp + m2; const int row = row0 + ai * HALF + m * 16;
                        const float rinv = __builtin_amdgcn_rsqf(rv[ai][m] * (1.0f / 1024.0f) + RMS_EPS);
                        f32x4 v[2];
#pragma unroll
                        for (int n = 0; n < 2; ++n) {
                            v[n] = acc[ai][bj][m][n] * rinv;
                            if (kind == 0) v[n] = v[n] * scale;
                            else {
#pragma unroll
                                for (int j = 0; j < 4; ++j) v[n][j] = sigm(v[n][j]);
                                if (kind == 1) {
#pragma unroll
                                    for (int j = 0; j < 4; ++j) v[n][j] = __builtin_amdgcn_logf(lb[bj][n][j] + (1.0f - lb[bj][n][j]) * v[n][j]) * 0.69314718056f;
                                }
                            }
                        }
                        if (!tr) {
                            u32x4 w; w.x = cvt_pk_bf16(v[0][0], v[0][1]); w.y = cvt_pk_bf16(v[0][2], v[0][3]); w.z = cvt_pk_bf16(v[1][0], v[1][1]); w.w = cvt_pk_bf16(v[1][2], v[1][3]);
                            *(u32x4*)(dst + (size_t)row * pitch + cbase + bj * HALF + cl) = w;
                        } else {
#pragma unroll
                            for (int n = 0; n < 2; ++n)
#pragma unroll
                                for (int j = 0; j < 4; ++j) tsw[(8 * fq + 4 * n + j) * 40 + m2 * 16 + fr] = (unsigned short)(cvt_pk_bf16(v[n][j], v[n][j]) & 0xffffu);
                        }
                    }
                    if (tr) {
                        const int lane = fq * 16 + fr, col = lane >> 1, half = lane & 1;
                        const u32x4 t0 = *(const PG8_LAS u32x4*)(tsw + col * 40 + half * 16), t1 = *(const PG8_LAS u32x4*)(tsw + col * 40 + half * 16 + 8);
                        bf16_t* tb = (pn == 2) ? VT : RIT; const int cw = (pn == 2) ? 128 : 512; const int c0 = ((pn == 2) ? 0 : cbase + bj * HALF) + wc * 32 + col;
                        const int rowg = u.pm * BM + ai * HALF + wr * 64 + mp * 32 + half * 16;
                        bf16_t* p = tb + (((size_t)((rowg >> 11) * cw + c0)) << 11) + (rowg & 2047);
                        *(u32x4*)p = t0; *(u32x4*)(p + 8) = t1;
                    }
                }
    }
};

template <bool ADD> struct EpiGate {
    static constexpr bool PERM = true, AFTER_DRAIN = false, ROWSTAT = false;
    const bf16_t* gate; bf16_t* MG;
    __device__ __forceinline__ void operator()(const f32x4 (&acc)[2][2][4][2], const Unit& u, int wr, int wc, int fr, int fq, const PG8_LAS float* rs, PG8_LAS float* xch, int tid) const {
        const int row0 = u.pm * BM + wr * 64 + fr, col0 = u.pn * BM + wc * 32 + 8 * fq;
        u32x4 gwb[2][2][2], pwb[2][2][2];
#define EG_LOAD(slot, g) do { _Pragma("unroll") for (int mm = 0; mm < 2; ++mm) _Pragma("unroll") for (int bj = 0; bj < 2; ++bj) { \
            const size_t off_ = (size_t)(row0 + ((g) >> 1) * HALF + (2 * ((g) & 1) + mm) * 16) * 1024 + col0 + bj * HALF; \
            gwb[slot][mm][bj] = *(const u32x4*)(gate + off_); if (ADD) pwb[slot][mm][bj] = *(const u32x4*)(MG + off_); } } while (0)
        EG_LOAD(0, 0);
#pragma unroll
        for (int g = 0; g < 4; ++g) {
            if (g + 1 < 4) EG_LOAD((g + 1) & 1, g + 1);
#pragma unroll
            for (int mm = 0; mm < 2; ++mm) {
                const int ai = g >> 1, m = 2 * (g & 1) + mm; const int row = row0 + ai * HALF + m * 16;
#pragma unroll
                for (int bj = 0; bj < 2; ++bj) {
                    const size_t off = (size_t)row * 1024 + col0 + bj * HALF;
                    f32x4 g0, g1; UNPK8(gwb[g & 1][mm][bj], g0, g1);
                    f32x4 o0 = g0 * acc[ai][bj][m][0], o1 = g1 * acc[ai][bj][m][1];
                    if (ADD) { f32x4 p0, p1; UNPK8(pwb[g & 1][mm][bj], p0, p1); o0 += p0; o1 += p1; }
                    u32x4 w; w.x = cvt_pk_bf16(o0[0], o0[1]); w.y = cvt_pk_bf16(o0[2], o0[3]); w.z = cvt_pk_bf16(o1[0], o1[1]); w.w = cvt_pk_bf16(o1[2], o1[3]);
                    *(u32x4*)(MG + off) = w;
                }
            }
        }
#undef EG_LOAD
    }
};

struct EpiStoreBf16 {
    static constexpr bool PERM = true, AFTER_DRAIN = false, ROWSTAT = false;
    bf16_t* T;
    __device__ __forceinline__ void operator()(const f32x4 (&acc)[2][2][4][2], const Unit& u, int wr, int wc, int fr, int fq, const PG8_LAS float* rs, PG8_LAS float* xch, int tid) const {
        const int row0 = u.pm * BM + wr * 64 + fr, col0 = u.pn * BM + wc * 32 + 8 * fq;
#pragma unroll
        for (int ai = 0; ai < 2; ++ai)
#pragma unroll
            for (int m = 0; m < 4; ++m) {
                const int row = row0 + ai * HALF + m * 16;
#pragma unroll
                for (int bj = 0; bj < 2; ++bj) {
                    const size_t off = (size_t)row * 1024 + col0 + bj * HALF;
                    const f32x4 a0 = acc[ai][bj][m][0], a1 = acc[ai][bj][m][1];
                    u32x4 w; w.x = cvt_pk_bf16(a0[0], a0[1]); w.y = cvt_pk_bf16(a0[2], a0[3]); w.z = cvt_pk_bf16(a1[0], a1[1]); w.w = cvt_pk_bf16(a1[2], a1[3]);
                    *(u32x4*)(T + off) = w;
                }
            }
    }
};

struct EpiPle2 {
    static constexpr bool PERM = true, AFTER_DRAIN = false, ROWSTAT = true;
    const float* ss; const bf16_t* T; const bf16_t* h3b; bf16_t* h4b; float* ssout;
    __device__ __forceinline__ void operator()(const f32x4 (&acc)[2][2][4][2], const Unit& u, int wr, int wc, int fr, int fq, const PG8_LAS float* rs, PG8_LAS float* xch, int tid) const {
        const int row0 = u.pm * BM + wr * 64 + fr, col0 = u.pn * BM + wc * 32 + 8 * fq;
        float rv[2][4];
#pragma unroll
        for (int ai = 0; ai < 2; ++ai)
#pragma unroll
            for (int m = 0; m < 4; ++m) { const f32x4 q4 = *(const PG8_LAS f32x4*)(rs + (ai * HALF + wr * 64 + m * 16 + fr) * 4); rv[ai][m] = (q4[0] + q4[1]) + (q4[2] + q4[3]); }
        u32x4 hwb[2][2], twb[2][2];
#define EP_LOAD(slot, g) do { _Pragma("unroll") for (int bj = 0; bj < 2; ++bj) { \
            const size_t off_ = (size_t)(row0 + ((g) >> 2) * HALF + ((g) & 3) * 16) * 1024 + col0 + bj * HALF; \
            hwb[slot][bj] = *(const u32x4*)(h3b + off_); twb[slot][bj] = *(const u32x4*)(T + off_); } } while (0)
        EP_LOAD(0, 0);
#pragma unroll
        for (int g = 0; g < 8; ++g) {
            if (g + 1 < 8) EP_LOAD((g + 1) & 1, g + 1);
            {
                const int ai = g >> 2, m = g & 3; const int row = row0 + ai * HALF + m * 16; float s = 0.f;
                const float rinv = __builtin_amdgcn_rsqf(rv[ai][m] * (1.0f / 1024.0f) + RMS_EPS);
#pragma unroll
                for (int bj = 0; bj < 2; ++bj) {
                    const size_t off = (size_t)row * 1024 + col0 + bj * HALF;
                    f32x4 b0, b1, t0, t1; UNPK8(hwb[g & 1][bj], b0, b1); UNPK8(twb[g & 1][bj], t0, t1);
                    f32x4 o0, o1;
#pragma unroll
                    for (int j = 0; j < 4; ++j) { o0[j] = b0[j] + sigm(acc[ai][bj][m][0][j] * rinv) * t0[j]; o1[j] = b1[j] + sigm(acc[ai][bj][m][1][j] * rinv) * t1[j]; }
                    u32x4 w; w.x = cvt_pk_bf16(o0[0], o0[1]); w.y = cvt_pk_bf16(o0[2], o0[3]); w.z = cvt_pk_bf16(o1[0], o1[1]); w.w = cvt_pk_bf16(o1[2], o1[3]);
                    *(u32x4*)(h4b + off) = w;
                    s += SUMSQ8(o0, o1);
                }
                s += __shfl_xor(s, 16); s += __shfl_xor(s, 32);
                if (fq == 0) xch[(row - u.pm * BM) * 4 + wc] = s;
            }
        }
#undef EP_LOAD
        asm volatile("s_waitcnt lgkmcnt(0)\n\ts_barrier" ::: "memory");
        if (tid < BM) { const f32x4 q4 = *(const PG8_LAS f32x4*)(xch + tid * 4); ssout[((size_t)u.pm * BM + tid) * 4 + u.pn] = (q4[0] + q4[1]) + (q4[2] + q4[3]); }
    }
};

template <class Epi, class Sched, bool ALIGN_EPI = false, bool SP2 = false>
__device__ __forceinline__ void gemm_phase(PG8_LAS unsigned char* lds, const Gemm g, const Sched& S, const Epi& E) {
    int tid_ = threadIdx.x; asm volatile("" : "+v"(tid_));
    const int tid = tid_, wid = __builtin_amdgcn_readfirstlane(tid >> 6), lane = tid & 63, wr = wid >> 2, wc = wid & 3, fr = lane & 15, fq = lane >> 4;
    const int K = g.K, nt = K / BK;
    unsigned voffA[2], voffB[2];
#pragma unroll
    for (int i = 0; i < 2; ++i) { int R, C; stage_rc(tid * 16 + i * 8192, R, C); const int Rb = Epi::PERM ? ((R & ~31) + perm32(R & 31)) : R;
        voffA[i] = (unsigned)(R * K + C) * 2u; voffB[i] = (unsigned)(Rb * K + C) * 2u; }
    const size_t kstep = (size_t)(BK * 2);
    const size_t hstep = (size_t)HALF * K * 2;
    const size_t tstep = 2 * hstep;
    const unsigned ldsw = (unsigned)wid * 1024u;
    const int aoff = lds_byte(wr * 64 + fr, fq * 8), boff = lds_byte(wc * 32 + fr, fq * 8);
#define PG8_SA(b, h) (((b) * 2 + (h)) * HTB)
#define PG8_SB(b, h) ((4 + (b) * 2 + (h)) * HTB)
#define PG8_STAGE(bufoff, gbase, voff) do { _Pragma("unroll") for (int _i = 0; _i < 2; ++_i) \
        __builtin_amdgcn_global_load_lds((const unsigned*)((const char*)(gbase) + (voff)[_i]), (PG8_LAS unsigned*)(lds + (bufoff) + ldsw + _i * 8192), 16, 0, 0); } while (0)
#define PG8_LDA(dst, b, h) do { _Pragma("unroll") for (int m = 0; m < 4; ++m) _Pragma("unroll") for (int k = 0; k < 2; ++k) dst[m][k] = *(const PG8_LAS bf16x8*)(lds + PG8_SA(b, h) + aoff + m * 2048 + k * 1024); } while (0)
#define PG8_LDB(dst, b, h) do { _Pragma("unroll") for (int n = 0; n < 2; ++n) _Pragma("unroll") for (int k = 0; k < 2; ++k) dst[n][k] = *(const PG8_LAS bf16x8*)(lds + PG8_SB(b, h) + boff + n * 2048 + k * 1024); } while (0)
#define PG8_MMA(ai, bj, At, Bt) do { __builtin_amdgcn_s_setprio(1); _Pragma("unroll") for (int m = 0; m < 4; ++m) _Pragma("unroll") for (int n = 0; n < 2; ++n) _Pragma("unroll") for (int k = 0; k < 2; ++k) \
        acc[ai][bj][m][n] = __builtin_amdgcn_mfma_f32_16x16x32_bf16(Bt[n][k], At[m][k], acc[ai][bj][m][n], 0, 0, 0); __builtin_amdgcn_s_setprio(0); } while (0)
#define PG8_WAIT_V(n) asm volatile("s_waitcnt vmcnt(" #n ")" ::: "memory")
#define PG8_WAIT_L(n) asm volatile("s_waitcnt lgkmcnt(" #n ")" ::: "memory")
#define PG8_BAR __builtin_amdgcn_s_barrier()
#define PG8_SCHED __builtin_amdgcn_sched_barrier(0)
    Unit cur, nxt; int ui = 0;
    if (!S.next(0, cur)) return;
#define PG8_ROWSTAT_DMA(unit_, ui_) do { if constexpr (Epi::ROWSTAT) { if (wid < 4) { unsigned keep_; const float* gp_ = E.ss + ((size_t)(unit_).pm * BM + wid * 64 + lane) * 4; \
        const unsigned dst_ = (unsigned)__builtin_amdgcn_readfirstlane((int)((unsigned)(size_t)lds + 133120u + (unsigned)((ui_) & 1) * 4096u + (unsigned)wid * 1024u)); \
        asm volatile("s_mov_b32 %0, m0\n\ts_mov_b32 m0, %2\n\ts_nop 0\n\tglobal_load_lds_dwordx4 %1, off\n\ts_mov_b32 m0, %0" : "=&s"(keep_) : "v"(gp_), "s"(dst_) : "memory"); } } } while (0)
    PG8_ROWSTAT_DMA(cur, 0);
    f32x4 acc[2][2][4][2];
#pragma unroll
    for (int a = 0; a < 2; ++a)
#pragma unroll
        for (int b = 0; b < 2; ++b)
#pragma unroll
            for (int m = 0; m < 4; ++m)
#pragma unroll
                for (int n = 0; n < 2; ++n) acc[a][b][m][n] = (f32x4){0.f, 0.f, 0.f, 0.f};
    bf16x8 At[4][2], B0[2][2], B1[2][2];
    const char* cA = (const char*)g.A + (size_t)cur.pm * tstep; const char* cB = (const char*)g.Bt + (size_t)cur.pn * tstep;
    S.a_ready(cur);
    if constexpr (SP2) {
        PG8_STAGE(PG8_SB(0, 0), cB, voffB); PG8_STAGE(PG8_SB(0, 1), cB + hstep, voffB); PG8_STAGE(PG8_SA(0, 0), cA, voffA); PG8_STAGE(PG8_SA(0, 1), cA + hstep, voffA);
        if (wr == 1) PG8_BAR;
        PG8_WAIT_V(2); PG8_BAR;
        PG8_STAGE(PG8_SB(1, 0), cB + kstep, voffB); PG8_STAGE(PG8_SA(1, 0), cA + kstep, voffA); PG8_STAGE(PG8_SB(1, 1), cB + hstep + kstep, voffB);
        PG8_WAIT_V(6); PG8_BAR;
    } else {
        PG8_STAGE(PG8_SB(0, 0), cB, voffB); PG8_STAGE(PG8_SA(0, 0), cA, voffA); PG8_STAGE(PG8_SB(0, 1), cB + hstep, voffB); PG8_STAGE(PG8_SA(0, 1), cA + hstep, voffA);
        if (wr == 1) PG8_BAR;
        PG8_WAIT_V(4); PG8_BAR;
        PG8_STAGE(PG8_SB(1, 0), cB + kstep, voffB); PG8_STAGE(PG8_SA(1, 0), cA + kstep, voffA); PG8_STAGE(PG8_SB(1, 1), cB + hstep + kstep, voffB);
        PG8_WAIT_V(6); PG8_BAR;
    }
    for (;;) {
        const bool has_next = S.next(ui + 1, nxt);
        const char* nA = has_next ? (const char*)g.A + (size_t)nxt.pm * tstep : cA; const char* nB = has_next ? (const char*)g.Bt + (size_t)nxt.pn * tstep : cB;
        for (int t = 0; t < nt; t += 2) {
            const bool last = (t == nt - 2);
            const char* a1 = cA + (size_t)(t + 1) * kstep;
            const char* a2 = last ? nA : cA + (size_t)(t + 2) * kstep; const char* b2 = last ? nB : cB + (size_t)(t + 2) * kstep;
            const char* a3 = a2 + kstep; const char* b3 = b2 + kstep;
            if (last && has_next) S.a_ready(nxt);
            if constexpr (SP2) {
            PG8_LDB(B0, 0, 0); PG8_LDB(B1, 0, 1); PG8_SCHED; PG8_LDA(At, 0, 0); PG8_STAGE(PG8_SA(1, 1), a1 + hstep, voffA);
            PG8_WAIT_V(8); PG8_WAIT_L(0); PG8_BAR; PG8_MMA(0, 0, At, B0); PG8_MMA(0, 1, At, B1); PG8_BAR; PG8_SCHED;
            PG8_LDA(At, 0, 1); PG8_STAGE(PG8_SB(0, 0), b2, voffB); PG8_STAGE(PG8_SB(0, 1), b2 + hstep, voffB); PG8_STAGE(PG8_SA(0, 0), a2, voffA);
            PG8_WAIT_V(8); PG8_WAIT_L(0); PG8_BAR; PG8_MMA(1, 0, At, B0); PG8_MMA(1, 1, At, B1); PG8_BAR; PG8_SCHED;
            PG8_LDB(B0, 1, 0); PG8_LDB(B1, 1, 1); PG8_SCHED; PG8_LDA(At, 1, 0); PG8_STAGE(PG8_SA(0, 1), a2 + hstep, voffA);
            PG8_WAIT_V(8); PG8_WAIT_L(0); PG8_BAR; PG8_MMA(0, 0, At, B0); PG8_MMA(0, 1, At, B1); PG8_BAR; PG8_SCHED;
            PG8_LDA(At, 1, 1); PG8_STAGE(PG8_SB(1, 0), b3, voffB); PG8_STAGE(PG8_SB(1, 1), b3 + hstep, voffB); PG8_STAGE(PG8_SA(1, 0), a3, voffA);
            PG8_WAIT_V(8); PG8_WAIT_L(0); PG8_BAR; PG8_MMA(1, 0, At, B0); PG8_MMA(1, 1, At, B1); PG8_BAR; PG8_SCHED;
            } else {
            PG8_LDB(B0, 0, 0); PG8_SCHED; PG8_LDA(At, 0, 0); PG8_STAGE(PG8_SA(1, 1), a1 + hstep, voffA);
            PG8_WAIT_L(8); PG8_BAR; PG8_WAIT_L(0); PG8_MMA(0, 0, At, B0); PG8_BAR; PG8_SCHED;
            PG8_LDB(B1, 0, 1); PG8_STAGE(PG8_SB(0, 0), b2, voffB);
            PG8_BAR; PG8_WAIT_L(0); PG8_MMA(0, 1, At, B1); PG8_BAR;
            PG8_LDA(At, 0, 1); PG8_STAGE(PG8_SA(0, 0), a2, voffA);
            PG8_BAR; PG8_WAIT_L(0); PG8_MMA(1, 0, At, B0); PG8_BAR; PG8_SCHED;
            PG8_STAGE(PG8_SB(0, 1), b2 + hstep, voffB);
            PG8_WAIT_V(6); PG8_BAR; PG8_MMA(1, 1, At, B1); PG8_BAR;
            PG8_LDB(B0, 1, 0); PG8_SCHED; PG8_LDA(At, 1, 0); PG8_STAGE(PG8_SA(0, 1), a2 + hstep, voffA);
            PG8_WAIT_L(8); PG8_BAR; PG8_WAIT_L(0); PG8_MMA(0, 0, At, B0); PG8_BAR; PG8_SCHED;
            PG8_LDB(B1, 1, 1); PG8_STAGE(PG8_SB(1, 0), b3, voffB);
            PG8_BAR; PG8_WAIT_L(0); PG8_MMA(0, 1, At, B1); PG8_BAR;
            PG8_LDA(At, 1, 1); PG8_STAGE(PG8_SA(1, 0), a3, voffA);
            PG8_BAR; PG8_WAIT_L(0); PG8_MMA(1, 0, At, B0); PG8_BAR; PG8_SCHED;
            PG8_STAGE(PG8_SB(1, 1), b3 + hstep, voffB);
            PG8_WAIT_V(6); PG8_BAR; PG8_MMA(1, 1, At, B1); PG8_BAR;
            }
        }
        if constexpr (ALIGN_EPI) { if (wr == 0) PG8_BAR; }
        if constexpr (!Epi::AFTER_DRAIN) { int t2_ = threadIdx.x; asm volatile("" : "+v"(t2_)); const int l2_ = t2_ & 63, w2_ = __builtin_amdgcn_readfirstlane(t2_ >> 6);
            E(acc, cur, w2_ >> 2, w2_ & 3, l2_ & 15, l2_ >> 4, (const PG8_LAS float*)(lds + 133120 + (ui & 1) * 4096), (PG8_LAS float*)(lds + 141312), t2_); S.done(cur); }
        if (!has_next) break;
#pragma unroll
        for (int a = 0; a < 2; ++a)
#pragma unroll
            for (int b = 0; b < 2; ++b)
#pragma unroll
                for (int m = 0; m < 4; ++m)
#pragma unroll
                    for (int n = 0; n < 2; ++n) acc[a][b][m][n] = (f32x4){0.f, 0.f, 0.f, 0.f};
        cur = nxt; cA = nA; cB = nB; ++ui;
        if constexpr (ALIGN_EPI) { if (wr == 1) PG8_BAR; }
        PG8_ROWSTAT_DMA(cur, ui);
    }
    PG8_WAIT_V(0);
    if constexpr (!ALIGN_EPI) { if (wr == 0) PG8_BAR; }
    PG8_BAR;
    if constexpr (Epi::AFTER_DRAIN) { E.fused(acc, cur, wr, wc, fr, fq, lds, wid, lane); S.done(cur); }
#undef PG8_SA
#undef PG8_SB
#undef PG8_STAGE
#undef PG8_LDA
#undef PG8_LDB
#undef PG8_MMA
#undef PG8_WAIT_V
#undef PG8_WAIT_L
#undef PG8_BAR
#undef PG8_SCHED
#undef PG8_ROWSTAT_DMA
}
}

constexpr int MTOK = 65536, DM = 1024, DFF = 2816, SEQL = 2048, NBATCH = 32, INW = 4864, PLE = 256;
constexpr int LDS_BYTES = 163840;
#define LAS __attribute__((address_space(3)))
typedef unsigned short bf16_t;
typedef float f32x4 __attribute__((ext_vector_type(4)));
typedef unsigned u32x4 __attribute__((ext_vector_type(4)));
typedef unsigned u32x2 __attribute__((ext_vector_type(2)));

constexpr size_t MiB = 1u << 20;
constexpr size_t WS_SS = 948 * MiB;
constexpr size_t WS_BAR = 1536 * 1024;
constexpr int MISC_OFF = 132096;
constexpr size_t WS_W1IN = 2 * MiB;
constexpr size_t WS_W1OUT = WS_W1IN + (size_t)5632 * 1024 * 2;
constexpr size_t WS_WIN = WS_W1OUT + (size_t)1024 * 2816 * 2;
constexpr size_t WS_WATT = WS_WIN + (size_t)4864 * 1024 * 2;
constexpr size_t WS_WREC = WS_WATT + (size_t)1024 * 512 * 2;
constexpr size_t WS_WOUT = WS_WREC + (size_t)1024 * 512 * 2;
constexpr size_t WS_W2IN = WS_WOUT + (size_t)1024 * 1024 * 2;
constexpr size_t WS_W2OUT = WS_W2IN + (size_t)5632 * 1024 * 2;
constexpr size_t WS_WG = WS_W2OUT + (size_t)1024 * 2816 * 2;
constexpr size_t WS_WP = WS_WG + (size_t)1024 * 1024 * 2;
constexpr size_t WS_WEND = WS_WP + (size_t)1024 * 256 * 2;
static_assert(WS_WEND <= 52 * MiB, "weights");
constexpr size_t WS_HB = 52 * MiB;
constexpr size_t WS_PB = WS_HB + 128 * MiB;
constexpr size_t WS_ATT = WS_PB + 32 * MiB;
constexpr size_t WS_REC = WS_ATT + 64 * MiB;
constexpr size_t WS_A = WS_REC + 64 * MiB;
constexpr size_t WS_Q = WS_A;
constexpr size_t WS_K = WS_Q + 64 * MiB;
constexpr size_t WS_VT = WS_K + 16 * MiB;
constexpr size_t WS_RQ = WS_VT + 16 * MiB;
constexpr size_t WS_RG = WS_RQ + 64 * MiB;
constexpr size_t WS_RIT = WS_RG + 64 * MiB;
constexpr size_t WS_SG = WS_RIT + 64 * MiB;
constexpr size_t WS_GA = WS_SG + 64 * MiB;
constexpr size_t WS_GB = WS_GA + 128 * MiB;
constexpr size_t WS_END = WS_GB + 128 * MiB;
constexpr size_t WS_ACT = WS_A;
constexpr size_t WS_MG = WS_A;
constexpr size_t WS_T = WS_A;
static_assert(WS_END <= 948 * MiB && WS_SS + (size_t)5 * MTOK * 16 <= 1024 * MiB, "d_ws map");

__device__ __forceinline__ float bf2f(unsigned short b) { return __uint_as_float((unsigned)b << 16); }
__device__ __forceinline__ float bflo(unsigned w) { return __uint_as_float(w << 16); }
__device__ __forceinline__ float bfhi(unsigned w) { return __uint_as_float(w & 0xffff0000u); }
__device__ __forceinline__ unsigned pk2(float lo, float hi) { return pg8::cvt_pk_bf16(lo, hi); }
#define LDS_WAIT() asm volatile("s_waitcnt lgkmcnt(0)" ::: "memory")

__constant__ unsigned char T5_BUCKET[128] = {0, 1, 2, 3, 4, 5, 6, 7, 8, 9, 10, 11, 12, 13, 14, 15, 16, 16, 16, 17, 17, 18, 18, 18, 19, 19, 19, 20, 20, 20, 20, 21, 21, 21, 21, 22, 22, 22, 22, 22, 23, 23, 23, 23, 23, 23, 24, 24, 24, 24, 24, 24, 25, 25, 25, 25, 25, 25, 25, 26, 26, 26, 26, 26, 26, 26, 26, 27, 27, 27, 27, 27, 27, 27, 27, 27, 27, 28, 28, 28, 28, 28, 28, 28, 28, 28, 28, 29, 29, 29, 29, 29, 29, 29, 29, 29, 29, 29, 29, 30, 30, 30, 30, 30, 30, 30, 30, 30, 30, 30, 30, 30, 30, 31, 31, 31, 31, 31, 31, 31, 31, 31, 31, 31, 31, 31, 31, 31};

__device__ __forceinline__ void p0_transpose_item(const float* W, int K, int N, bf16_t* WT, const float* gain, int swz, LAS float* scr, int item, int lane) {
    const int nblk = N / 32, kb = item / nblk, nb = item % nblk, k0 = 64 * kb, n0 = 32 * nb;
    int drow0 = n0;
    if (swz) { const int up = n0 >= DFF ? 1 : 0; const int j = n0 - up * DFF; drow0 = 256 * (j >> 7) + (j & 127) + 128 * up; }
#pragma unroll
    for (int i = 0; i < 32; ++i) { const int kk = 2 * i + (lane >> 5); const float g = gain ? gain[k0 + kk] : 1.0f; scr[kk * 33 + (lane & 31)] = W[(size_t)(k0 + kk) * N + n0 + (lane & 31)] * g; }
    LDS_WAIT(); asm volatile("" ::: "memory");
    const int c = lane & 7;
#pragma unroll
    for (int j = 0; j < 4; ++j) { const int n = (lane >> 3) + 8 * j; const LAS float* s = scr + (8 * c) * 33 + n;
        u32x4 o; o.x = pk2(s[0 * 33], s[1 * 33]); o.y = pk2(s[2 * 33], s[3 * 33]); o.z = pk2(s[4 * 33], s[5 * 33]); o.w = pk2(s[6 * 33], s[7 * 33]);
        *(u32x4*)(WT + (size_t)(drow0 + n) * K + k0 + 8 * c) = o; }
    LDS_WAIT(); asm volatile("" ::: "memory");
}

struct Args { const float* in[21]; float* out; unsigned char* ws; };

__device__ __forceinline__ void p0_prologue(const Args& a, LAS unsigned char* lds, int tid, int lane, int wave, int G) {
    unsigned char* ws = a.ws;
    LAS float* scr = (LAS float*)(lds + wave * 16384);
    const int gw = blockIdx.x * 8 + wave, NGW = G * 8;
    constexpr int I1 = 16 * 176, I2 = 44 * 32, I3 = 16 * 152, I4 = 8 * 32, I6 = 16 * 32, I10 = 4 * 32;
    constexpr int NITEMS = I1 + I2 + I3 + I4 + I4 + I6 + I1 + I2 + I6 + I10;
    float* ss = (float*)(ws + WS_SS);
    bf16_t* HB = (bf16_t*)(ws + WS_HB);
    for (int pass = 0; pass < 2; ++pass) {
    if ((pass ^ (wave & 1)) == 0) {
    for (int it = gw; it < NITEMS; it += NGW) {
        int r = it;
        if (r < I1) { p0_transpose_item(a.in[5], 1024, 5632, (bf16_t*)(ws + WS_W1IN), a.in[4], 1, scr, r, lane); continue; } r -= I1;
        if (r < I2) { p0_transpose_item(a.in[6], 2816, 1024, (bf16_t*)(ws + WS_W1OUT), nullptr, 0, scr, r, lane); continue; } r -= I2;
        if (r < I3) { p0_transpose_item(a.in[8], 1024, 4864, (bf16_t*)(ws + WS_WIN), a.in[7], 0, scr, r, lane); continue; } r -= I3;
        if (r < I4) { p0_transpose_item(a.in[11], 512, 1024, (bf16_t*)(ws + WS_WATT), nullptr, 0, scr, r, lane); continue; } r -= I4;
        if (r < I4) { p0_transpose_item(a.in[12], 512, 1024, (bf16_t*)(ws + WS_WREC), nullptr, 0, scr, r, lane); continue; } r -= I4;
        if (r < I6) { p0_transpose_item(a.in[13], 1024, 1024, (bf16_t*)(ws + WS_WOUT), nullptr, 0, scr, r, lane); continue; } r -= I6;
        if (r < I1) { p0_transpose_item(a.in[15], 1024, 5632, (bf16_t*)(ws + WS_W2IN), a.in[14], 1, scr, r, lane); continue; } r -= I1;
        if (r < I2) { p0_transpose_item(a.in[16], 2816, 1024, (bf16_t*)(ws + WS_W2OUT), nullptr, 0, scr, r, lane); continue; } r -= I2;
        if (r < I6) { p0_transpose_item(a.in[18], 1024, 1024, (bf16_t*)(ws + WS_WG), a.in[17], 0, scr, r, lane); continue; } r -= I6;
        p0_transpose_item(a.in[19], 256, 1024, (bf16_t*)(ws + WS_WP), nullptr, 0, scr, r, lane);
    }
    } else {
    for (int m = gw; m < MTOK; m += 4 * NGW) {
        f32x4 v[4][4]; float s[4];
#pragma unroll
        for (int q = 0; q < 4; ++q) { const int mq = (m + q * NGW < MTOK) ? m + q * NGW : m; const f32x4* xr = (const f32x4*)(a.in[0] + (size_t)mq * DM) + lane;
#pragma unroll
            for (int j = 0; j < 4; ++j) v[q][j] = xr[64 * j]; }
#pragma unroll
        for (int q = 0; q < 4; ++q) { s[q] = 0.f;
#pragma unroll
            for (int j = 0; j < 4; ++j) s[q] += (v[q][j].x * v[q][j].x + v[q][j].y * v[q][j].y) + (v[q][j].z * v[q][j].z + v[q][j].w * v[q][j].w); }
#pragma unroll
        for (int o = 1; o < 64; o <<= 1) {
#pragma unroll
            for (int q = 0; q < 4; ++q) s[q] += __shfl_xor(s[q], o); }
#pragma unroll
        for (int q = 0; q < 4; ++q) { const int mq = m + q * NGW;
            if (mq < MTOK) { u32x2* o8 = (u32x2*)(HB + (size_t)mq * DM) + lane;
#pragma unroll
                for (int j = 0; j < 4; ++j) { u32x2 w; w.x = pk2(v[q][j].x, v[q][j].y); w.y = pk2(v[q][j].z, v[q][j].w); o8[64 * j] = w; }
                if (lane == 0) *(f32x4*)(ss + (size_t)mq * 4) = (f32x4){s[q], 0.f, 0.f, 0.f}; } }
    }
    }
    }
    const int gt = blockIdx.x * 512 + tid, NGT = G * 512;
    bf16_t* PB = (bf16_t*)(ws + WS_PB);
    for (int i = gt; i < MTOK * PLE / 8; i += 4 * NGT) {
        f32x4 p0[4], p1[4];
#pragma unroll
        for (int q = 0; q < 4; ++q) { const int iq = (i + q * NGT < MTOK * PLE / 8) ? i + q * NGT : i; p0[q] = ((const f32x4*)a.in[1])[2 * iq]; p1[q] = ((const f32x4*)a.in[1])[2 * iq + 1]; }
#pragma unroll
        for (int q = 0; q < 4; ++q) { const int iq = i + q * NGT;
            if (iq < MTOK * PLE / 8) { u32x4 w; w.x = pk2(p0[q].x, p0[q].y); w.y = pk2(p0[q].z, p0[q].w); w.z = pk2(p1[q].x, p1[q].y); w.w = pk2(p1[q].z, p1[q].w); ((u32x4*)PB)[iq] = w; } }
    }
}


struct PartOrder {
    pg8::StaticOrder S; int pm0;
    __device__ void init(int Mpart, int N, int G, int c, int pm0_) { S.init(Mpart, N, G, c); pm0 = pm0_; }
    __device__ bool next(int i, pg8::Unit& u) const { const bool r = S.next(i, u); u.pm += pm0; return r; }
    __device__ __forceinline__ void a_ready(const pg8::Unit&) const {}
    __device__ __forceinline__ void done(const pg8::Unit&) const {}
};

struct RevOrder {
    pg8::StaticOrder S; int nr;
    __device__ void init(int M, int N, int G, int c) { S.init(M, N, G, c); nr = (S.nwg + G - 1) / G; }
    __device__ bool next(int i, pg8::Unit& u) const { if (i >= nr) return false; return S.next(nr - 1 - i, u); }
    __device__ __forceinline__ void a_ready(const pg8::Unit&) const {}
    __device__ __forceinline__ void done(const pg8::Unit&) const {}
};
#define XB_TMO      128
#define XB_XCNT(j)  (256  + 64 * (j))
#define XB_XSUB(j)  (1280 + 64 * (j))
#define XB_XGEN(j)  (2304 + 64 * (j))
#define XB_TOP      3328
#define XB_TOPGEN   3392
#define XCD_BAR_WORDS 3456
#define XB_SPIN_CAP (1u << 18)

__device__ __forceinline__ unsigned xb_ld(unsigned* p)              { return __hip_atomic_load(p, __ATOMIC_RELAXED, __HIP_MEMORY_SCOPE_AGENT); }
__device__ __forceinline__ unsigned xb_add(unsigned* p, unsigned v) { return __hip_atomic_fetch_add(p, v, __ATOMIC_RELAXED, __HIP_MEMORY_SCOPE_AGENT); }
__device__ __forceinline__ unsigned xb_xcc_id() { return (unsigned)__builtin_amdgcn_s_getreg((3 << 11) | 20) & 0xFu; }
#define XB_SPIN(cond, bar) do { unsigned _sp = 0; while (cond) { __builtin_amdgcn_s_sleep(1); \
    if ((++_sp & 255u) == 0u) { if (xb_ld(&(bar)[XB_TMO])) break; if (_sp > XB_SPIN_CAP) { atomicAdd(&(bar)[XB_TMO], 1u); break; } } } } while (0)

struct XcdBarrier {
    unsigned* bar; unsigned x;
    volatile LAS unsigned* st;
};

__device__ __forceinline__ XcdBarrier xcd_barrier_post(unsigned* bar, volatile LAS unsigned* st) {
    XcdBarrier b; b.bar = bar; b.x = xb_xcc_id(); b.st = st;
    if (threadIdx.x == 0) (void)xb_add(&bar[XB_XCNT(b.x)], 1u);
    return b;
}
__device__ __forceinline__ void xcd_barrier_complete(unsigned* bar, unsigned x, unsigned& nloc, unsigned& nx) {
    const unsigned G = gridDim.x * gridDim.y * gridDim.z;
    unsigned sum, cnt, mine, sp = 0u;
    for (;;) {
        sum = 0u; cnt = 0u; mine = 0u;
#pragma unroll
        for (unsigned j = 0; j < 16; ++j) { const unsigned c = xb_ld(&bar[XB_XCNT(j)]); sum += c; cnt += (c > 0u) ? 1u : 0u; mine = (j == x) ? c : mine; }
        if (sum == G) break;
        __builtin_amdgcn_s_sleep(1);
        if ((++sp & 255u) == 0u) { if (xb_ld(&bar[XB_TMO])) break; if (sp > XB_SPIN_CAP) { atomicAdd(&bar[XB_TMO], 1u); break; } }
    }
    nloc = mine > 0u ? mine : 1u; nx = cnt > 0u ? cnt : 1u;
}

__device__ __forceinline__ void xcd_barrier(const XcdBarrier& b) {
    asm volatile("s_waitcnt vmcnt(0)" ::: "memory");
    __syncthreads();
    if (threadIdx.x == 0) {
        unsigned* bar = b.bar;
        __builtin_amdgcn_s_waitcnt(0);
        unsigned nloc = b.st[0], nx = b.st[1];
        if (nloc == 0u) { xcd_barrier_complete(bar, b.x, nloc, nx); b.st[0] = nloc; b.st[1] = nx; }
        const unsigned old = xb_add(&bar[XB_XSUB(b.x)], 1u);
        const unsigned gen = old / nloc;
        if (old + 1u == (gen + 1u) * nloc) {
            __builtin_amdgcn_fence(__ATOMIC_RELEASE, "agent");
            asm volatile("s_waitcnt vmcnt(0)" ::: "memory");
            const unsigned og = xb_add(&bar[XB_TOP], 1u);
            const unsigned tg = og / nx;
            if (og + 1u == (tg + 1u) * nx) xb_add(&bar[XB_TOPGEN], 1u);
            else XB_SPIN(xb_ld(&bar[XB_TOPGEN]) == tg, bar);
            __builtin_amdgcn_fence(__ATOMIC_ACQUIRE, "agent");
            xb_add(&bar[XB_XGEN(b.x)], 1u);
            asm volatile("s_waitcnt vmcnt(0)" ::: "memory");
        } else {
            XB_SPIN(xb_ld(&bar[XB_XGEN(b.x)]) == gen, bar);
            __builtin_amdgcn_fence(__ATOMIC_ACQUIRE, "agent");
            asm volatile("s_waitcnt vmcnt(0)" ::: "memory");
        }
    }
    __syncthreads();
}
typedef short bf16x8 __attribute__((ext_vector_type(8)));
typedef float f32x16 __attribute__((ext_vector_type(16)));
typedef float f32x2_t __attribute__((ext_vector_type(2)));
typedef __bf16 bf16x2_t __attribute__((ext_vector_type(2)));
__device__ __forceinline__ unsigned cvtpk_s(float lo, float hi) { f32x2_t v = {lo, hi}; bf16x2_t b = __builtin_convertvector(v, bf16x2_t); return __builtin_bit_cast(unsigned, b); }
__device__ __forceinline__ float ex(float x) { return __builtin_amdgcn_exp2f(x * 1.44269504f); }
#define LBAR() asm volatile("s_waitcnt lgkmcnt(0)\n\ts_barrier" ::: "memory")
#define MFMA32(a, b, c) __builtin_amdgcn_mfma_f32_32x32x16_bf16((a), (b), (c), 0, 0, 0)
__device__ __forceinline__ int crow(int r, int hi) { return (r & 3) + 8 * (r >> 2) + 4 * hi; }
__device__ __forceinline__ bf16x8 pack8(const f32x16& x, int s) {
    u32x4 p; p.x = cvtpk_s(x[8 * s], x[8 * s + 1]); p.y = cvtpk_s(x[8 * s + 2], x[8 * s + 3]); p.z = cvtpk_s(x[8 * s + 4], x[8 * s + 5]); p.w = cvtpk_s(x[8 * s + 6], x[8 * s + 7]);
    return __builtin_bit_cast(bf16x8, p);
}
__device__ __forceinline__ bf16x8 ld2x8(const LAS unsigned char* p) {
    const u32x2 lo = *(const LAS u32x2*)p, hi = *(const LAS u32x2*)(p + 16);
    u32x4 v; v.x = lo.x; v.y = lo.y; v.z = hi.x; v.w = hi.y; return __builtin_bit_cast(bf16x8, v);
}

__device__ __forceinline__ void attn_mfma_units(LAS unsigned char* lds, int u0, int ustride, int nunits, const bf16_t* Q, const bf16_t* Kb, const bf16_t* VT, const float* relb, const float* sinks, bf16_t* ATT, int tid) {
    constexpr int KP = 144, VP = 520;
    constexpr float LOG2E = 1.44269504f;
    LAS unsigned char* Ks = lds; LAS unsigned char* Vs = lds + 256 * KP; LAS float* ext = (LAS float*)(lds + 256 * KP + 64 * VP);
    const int lane = tid & 63, wv = tid >> 6, g = wv >> 1, l32 = lane & 31, hi = lane >> 5;
    const int skey = tid >> 1, shalf = tid & 1, sd = tid >> 3, sseg = tid & 7;
    u32x4 kw[4], vw[4];
#define AT_LOAD(u_) do { const int b_ = (u_) >> 5, n_ = ((u_) >> 1) & 15, hk_ = (u_) & 1; \
        const int kpos_ = n_ * 128 - 128 + skey, vpos_ = n_ * 128 - 128 + sseg * 32; \
        const u32x4* ks_ = (const u32x4*)(Kb + (size_t)(b_ * SEQL + (kpos_ < 0 ? 0 : kpos_)) * 128 + hk_ * 64 + shalf * 32); \
        const u32x4* vs_ = (const u32x4*)(VT + ((size_t)((b_ * 2 + hk_) * 64 + sd) << 11) + (vpos_ < 0 ? 0 : vpos_)); \
        _Pragma("unroll") for (int i = 0; i < 4; ++i) { kw[i] = ks_[i]; vw[i] = vs_[i]; } \
        if (kpos_ < 0) { _Pragma("unroll") for (int i = 0; i < 4; ++i) kw[i] = (u32x4){0u, 0u, 0u, 0u}; } \
        if (vpos_ < 0) { _Pragma("unroll") for (int i = 0; i < 4; ++i) vw[i] = (u32x4){0u, 0u, 0u, 0u}; } } while (0)
    if (u0 < nunits) AT_LOAD(u0);
    for (int unit = u0; unit < nunits; unit += ustride) {
        const int b = unit >> 5, n = (unit >> 1) & 15, hk = unit & 1, head = hk * 4 + g;
        {   LAS u32x4* d = (LAS u32x4*)(Ks + skey * KP + shalf * 64);
#pragma unroll
            for (int i = 0; i < 4; ++i) d[i] = kw[i];
            LAS u32x2* dd = (LAS u32x2*)(Vs + sd * VP + sseg * 64);
#pragma unroll
            for (int i = 0; i < 4; ++i) { u32x2 a; a.x = vw[i].x; a.y = vw[i].y; u32x2 c; c.x = vw[i].z; c.y = vw[i].w; dd[2 * i] = a; dd[2 * i + 1] = c; }
            for (int i = tid; i < 4 * 192; i += 512) { const int gg = i / 192, dist = i % 192 - 32;
                ext[i] = (dist >= 0 && dist < 128) ? relb[(int)T5_BUCKET[dist & 127] * 8 + hk * 4 + gg] * LOG2E : -INFINITY; }
        }
        bf16x8 qc[2][4];
#pragma unroll
        for (int sb = 0; sb < 2; ++sb) { const size_t row_ = (size_t)b * SEQL + n * 128 + 32 * (2 * (wv & 1) + sb) + l32;
#pragma unroll
            for (int ds = 0; ds < 4; ++ds) qc[sb][ds] = *(const bf16x8*)(Q + row_ * 512 + head * 64 + 16 * ds + 8 * hi); }
        LBAR();
        if (unit + ustride < nunits) AT_LOAD(unit + ustride);
        const float sink = sinks[head] * LOG2E;
        const LAS float* ex0 = ext + g * 192 + l32 - 4 * hi;
#pragma unroll
        for (int sb = 0; sb < 2; ++sb) {
            const int a = 2 * (wv & 1) + sb;
            const size_t row = (size_t)b * SEQL + n * 128 + 32 * a + l32;
            f32x16 S[5];
            {   bf16x8 kfr[2][4];
#pragma unroll
                for (int ds = 0; ds < 4; ++ds) kfr[0][ds] = *(const LAS bf16x8*)(Ks + (32 * a + l32) * KP + (16 * ds + 8 * hi) * 2);
#pragma unroll
                for (int t = 0; t < 5; ++t) {
                    if (t + 1 < 5) {
#pragma unroll
                        for (int ds = 0; ds < 4; ++ds) kfr[(t + 1) & 1][ds] = *(const LAS bf16x8*)(Ks + (32 * (a + t + 1) + l32) * KP + (16 * ds + 8 * hi) * 2);
                    }
                    f32x16 acc;
#pragma unroll
                    for (int r = 0; r < 16; ++r) acc[r] = 0.f;
#pragma unroll
                    for (int ds = 0; ds < 4; ++ds) acc = MFMA32(kfr[t & 1][ds], qc[sb][ds], acc);
                    S[t] = acc;
                }
            }
            float mx = sink;
#pragma unroll
            for (int t = 0; t < 5; ++t) {
                const bool dead = (n == 0) && (a + t < 4);
#pragma unroll
                for (int r = 0; r < 16; ++r) {
                    float sv = __builtin_fmaf(S[t][r], LOG2E, ex0[160 - 32 * t - (r & 3) - 8 * (r >> 2)]);
                    sv = dead ? -INFINITY : sv;
                    S[t][r] = sv; mx = fmaxf(mx, sv);
                }
            }
            mx = fmaxf(mx, __shfl_xor(mx, 32));
            float l = 0.f;
#pragma unroll
            for (int t = 0; t < 5; ++t)
#pragma unroll
                for (int r = 0; r < 16; ++r) { const float p = __builtin_amdgcn_exp2f(S[t][r] - mx); S[t][r] = p; l += p; }
            l += __shfl_xor(l, 32); l += __builtin_amdgcn_exp2f(sink - mx);
            f32x16 O[2];
#pragma unroll
            for (int dt = 0; dt < 2; ++dt)
#pragma unroll
                for (int r = 0; r < 16; ++r) O[dt][r] = 0.f;
            {   bf16x8 vfr[2][4];
#pragma unroll
                for (int i = 0; i < 4; ++i) vfr[0][i] = ld2x8(Vs + (l32 + 32 * (i & 1)) * VP + (32 * a + 16 * (i >> 1) + 4 * hi) * 2);
#pragma unroll
                for (int t = 0; t < 5; ++t) {
                    if (t + 1 < 5) {
#pragma unroll
                        for (int i = 0; i < 4; ++i) vfr[(t + 1) & 1][i] = ld2x8(Vs + (l32 + 32 * (i & 1)) * VP + (32 * (a + t + 1) + 16 * (i >> 1) + 4 * hi) * 2);
                    }
#pragma unroll
                    for (int kb = 0; kb < 2; ++kb) {
                        const bf16x8 pf = pack8(S[t], kb);
#pragma unroll
                        for (int dt = 0; dt < 2; ++dt) O[dt] = MFMA32(vfr[t & 1][2 * kb + dt], pf, O[dt]);
                    }
                }
            }
            const float rl = 1.0f / l;
#pragma unroll
            for (int dt = 0; dt < 2; ++dt)
#pragma unroll
                for (int c4 = 0; c4 < 4; ++c4) {
                    u32x2 w; w.x = cvtpk_s(O[dt][4 * c4] * rl, O[dt][4 * c4 + 1] * rl); w.y = cvtpk_s(O[dt][4 * c4 + 2] * rl, O[dt][4 * c4 + 3] * rl);
                    *(u32x2*)(ATT + row * 512 + head * 64 + 32 * dt + 8 * c4 + 4 * hi) = w;
                }
            asm volatile("" ::: "memory");
        }
        LBAR();
    }
#undef AT_LOAD
}

__device__ __forceinline__ void rec_mfma_unit(LAS unsigned char* lds, int unit, const bf16_t* RQ, const bf16_t* RG, const bf16_t* RIT, const bf16_t* SG, const float* recnorm, bf16_t* REC, int tid) {
    constexpr int PQ = 272, PK = 144;
    LAS unsigned char* QT = lds;
    LAS unsigned char* KT = lds + 17408;
    LAS unsigned char* KH = lds + 34816;
    LAS unsigned char* VS = lds + 53248;
    LAS unsigned char* ST = lds + 71680;
    LAS float* GM = (LAS float*)(lds + 106496);
    LAS float* SEG = (LAS float*)(lds + 107008);
    LAS float* PSS = (LAS float*)(lds + 111104);
    LAS float* GN = (LAS float*)(lds + 129536);
    LAS unsigned char* OT = lds + 112128;
    const int b = unit >> 2, h = unit & 3;
    const int lane = tid & 63, wv = tid >> 6, l32 = lane & 31, hi = lane >> 5;
    const size_t R0 = (size_t)b * SEQL;
    const int cp = lane, tseg = wv;
    const bf16_t* gsrc = RG + (R0 + 8 * tseg) * 512 + h * 128 + 2 * cp;
    const bf16_t* qsrc = RQ + (R0 + 8 * tseg) * 512 + h * 128 + 2 * cp;
    const int vdv = tid >> 2, vpart = tid & 3;
    const bf16_t* vsrc = RIT + (((size_t)((b * 4 + h) * 128 + vdv)) << 11) + vpart * 16;
    const int dvi = wv >> 1, tj = ((wv >> 2) ^ wv) & 1;
    const int di = wv >> 1, dj0 = 2 * (wv & 1);
    const int trow = 32 * tj + l32;
    const int wt = tid >> 3, wp = tid & 7;
    const size_t woff = (R0 + wt) * 512 + h * 128 + wp * 16;
    f32x16 SA[2];
#pragma unroll
    for (int x = 0; x < 2; ++x)
#pragma unroll
        for (int r = 0; r < 16; ++r) SA[x][r] = 0.f;
    if (tid < 128) GN[tid] = recnorm[tid];
    unsigned gw[8], qw[8]; u32x4 vw[2]; u32x4 sgw[2];
    sgw[0] = (u32x4){0u, 0u, 0u, 0u}; sgw[1] = sgw[0];
#pragma unroll
    for (int tt = 0; tt < 8; ++tt) { gw[tt] = *(const unsigned*)(gsrc + tt * 512); qw[tt] = *(const unsigned*)(qsrc + tt * 512); }
    vw[0] = *(const u32x4*)(vsrc); vw[1] = *(const u32x4*)(vsrc + 8);
#define REC_WRITEOUT(cc) do { const LAS u32x4* op_ = (const LAS u32x4*)(OT + wt * PQ + wp * 32); \
        _Pragma("unroll") for (int i_ = 0; i_ < 2; ++i_) { const u32x4 ov_ = op_[i_]; f32x4 a0_, a1_, s0_, s1_; \
            a0_ = (f32x4){bflo(ov_.x), bfhi(ov_.x), bflo(ov_.y), bfhi(ov_.y)}; a1_ = (f32x4){bflo(ov_.z), bfhi(ov_.z), bflo(ov_.w), bfhi(ov_.w)}; \
            s0_ = (f32x4){bflo(sgw[i_].x), bfhi(sgw[i_].x), bflo(sgw[i_].y), bfhi(sgw[i_].y)}; s1_ = (f32x4){bflo(sgw[i_].z), bfhi(sgw[i_].z), bflo(sgw[i_].w), bfhi(sgw[i_].w)}; \
            a0_ = a0_ * s0_; a1_ = a1_ * s1_; u32x4 w_; w_.x = cvtpk_s(a0_[0], a0_[1]); w_.y = cvtpk_s(a0_[2], a0_[3]); w_.z = cvtpk_s(a1_[0], a1_[1]); w_.w = cvtpk_s(a1_[2], a1_[3]); \
            *(u32x4*)(REC + woff + (size_t)(cc) * 64 * 512 + 8 * i_) = w_; } } while (0)
    for (int c = 0; c < 32; ++c) {
        f32x2_t fv[8], cpv[8]; f32x2_t run = {1.f, 1.f};
#pragma unroll
        for (int tt = 0; tt < 8; ++tt) { fv[tt].x = ex(bflo(gw[tt])); fv[tt].y = ex(bfhi(gw[tt])); run = run * fv[tt]; cpv[tt] = run; }
        *(LAS f32x2_t*)(SEG + tseg * 128 + 2 * cp) = run;
        LBAR();
        if (c > 0) REC_WRITEOUT(c - 1);
        f32x2_t pre = {1.f, 1.f}, tot = {1.f, 1.f};
#pragma unroll
        for (int s = 0; s < 8; ++s) { const f32x2_t v = *(const LAS f32x2_t*)(SEG + s * 128 + 2 * cp); tot = tot * v; if (s < tseg) pre = pre * v; }
        f32x2_t kh[8];
#pragma unroll
        for (int tt = 0; tt < 8; ++tt) {
            const f32x2_t E = pre * cpv[tt];
            f32x2_t rE; rE.x = fminf(__builtin_amdgcn_rcpf(E.x), 5.5e34f); rE.y = fminf(__builtin_amdgcn_rcpf(E.y), 5.5e34f);
            const f32x2_t k = 1.0f - fv[tt];
            f32x2_t qv; qv.x = bflo(qw[tt]); qv.y = bfhi(qw[tt]);
            const f32x2_t qt = qv * E, kt = k * rE;
            kh[tt] = k * (tot * rE);
            *(LAS unsigned*)(QT + (8 * tseg + tt) * PQ + 4 * cp) = cvtpk_s(qt.x, qt.y);
            *(LAS unsigned*)(KT + (8 * tseg + tt) * PQ + 4 * cp) = cvtpk_s(kt.x, kt.y);
        }
        { u32x4 w0, w1; w0.x = cvtpk_s(kh[0].x, kh[1].x); w0.y = cvtpk_s(kh[2].x, kh[3].x); w0.z = cvtpk_s(kh[4].x, kh[5].x); w0.w = cvtpk_s(kh[6].x, kh[7].x);
          w1.x = cvtpk_s(kh[0].y, kh[1].y); w1.y = cvtpk_s(kh[2].y, kh[3].y); w1.z = cvtpk_s(kh[4].y, kh[5].y); w1.w = cvtpk_s(kh[6].y, kh[7].y);
          *(LAS u32x4*)(KH + (2 * cp) * PK + 16 * tseg) = w0; *(LAS u32x4*)(KH + (2 * cp + 1) * PK + 16 * tseg) = w1; }
        if (tseg == 0) *(LAS f32x2_t*)(GM + 2 * cp) = tot;
        *(LAS u32x4*)(VS + vdv * PK + vpart * 32) = vw[0]; *(LAS u32x4*)(VS + vdv * PK + vpart * 32 + 16) = vw[1];
        LBAR();
        if (c + 1 < 32) {
            const size_t adv = (size_t)(c + 1) * 64;
#pragma unroll
            for (int tt = 0; tt < 8; ++tt) { gw[tt] = *(const unsigned*)(gsrc + (adv + tt) * 512); qw[tt] = *(const unsigned*)(qsrc + (adv + tt) * 512); }
            vw[0] = *(const u32x4*)(vsrc + adv); vw[1] = *(const u32x4*)(vsrc + adv + 8);
        }
        sgw[0] = *(const u32x4*)(SG + woff + (size_t)c * 64 * 512); sgw[1] = *(const u32x4*)(SG + woff + (size_t)c * 64 * 512 + 8);
        bf16x8 qf[8], kf[8];
#pragma unroll
        for (int ks = 0; ks < 8; ++ks) qf[ks] = *(const LAS bf16x8*)(QT + trow * PQ + (16 * ks + 8 * hi) * 2);
#pragma unroll
        for (int ks = 0; ks < 8; ++ks) kf[ks] = *(const LAS bf16x8*)(KT + l32 * PQ + (16 * ks + 8 * hi) * 2);
        bf16x8 vf[2];
#pragma unroll
        for (int kb = 0; kb < 2; ++kb) vf[kb] = ld2x8(VS + (32 * dvi + l32) * PK + (16 * kb + 4 * hi) * 2);
        f32x16 at0, at1;
#pragma unroll
        for (int r = 0; r < 16; ++r) { at0[r] = 0.f; at1[r] = 0.f; }
#pragma unroll
        for (int ks = 0; ks < 8; ++ks) at0 = MFMA32(kf[ks], qf[ks], at0);
        if (tj) {
#pragma unroll
            for (int ks = 0; ks < 8; ++ks) kf[ks] = *(const LAS bf16x8*)(KT + (32 + l32) * PQ + (16 * ks + 8 * hi) * 2);
#pragma unroll
            for (int ks = 0; ks < 8; ++ks) at1 = MFMA32(kf[ks], qf[ks], at1);
#pragma unroll
            for (int r = 0; r < 16; ++r) at1[r] = (crow(r, hi) <= l32) ? at1[r] : 0.f;
        } else {
#pragma unroll
            for (int r = 0; r < 16; ++r) at0[r] = (crow(r, hi) <= l32) ? at0[r] : 0.f;
        }
        if (c > 0) {
#pragma unroll
            for (int ks = 0; ks < 8; ++ks) kf[ks] = *(const LAS bf16x8*)(ST + (32 * dvi + l32) * PQ + (16 * ks + 8 * hi) * 2);
        }
        f32x16 oacc;
#pragma unroll
        for (int r = 0; r < 16; ++r) oacc[r] = 0.f;
#pragma unroll
        for (int kb = 0; kb < 2; ++kb) { const bf16x8 pf = pack8(at0, kb); oacc = MFMA32(vf[kb], pf, oacc); }
        if (tj) {
            bf16x8 vg[2];
#pragma unroll
            for (int kb = 0; kb < 2; ++kb) vg[kb] = ld2x8(VS + (32 * dvi + l32) * PK + (32 + 16 * kb + 4 * hi) * 2);
#pragma unroll
            for (int kb = 0; kb < 2; ++kb) { const bf16x8 pf = pack8(at1, kb); oacc = MFMA32(vg[kb], pf, oacc); }
        }
        if (c > 0) {
#pragma unroll
            for (int ks = 0; ks < 8; ++ks) oacc = MFMA32(kf[ks], qf[ks], oacc);
        }
        { float ps = 0.f;
#pragma unroll
          for (int r = 0; r < 16; ++r) ps += oacc[r] * oacc[r];
          ps += __shfl_xor(ps, 32);
          if (hi == 0) PSS[dvi * 64 + trow] = ps; }
        LBAR();
        {   const float tot2 = (PSS[trow] + PSS[64 + trow]) + (PSS[128 + trow] + PSS[192 + trow]);
            const float rinv = __builtin_amdgcn_rsqf(tot2 * (1.0f / 128.0f) + 1e-6f);
#pragma unroll
            for (int c4 = 0; c4 < 4; ++c4) {
                const f32x4 gnv = *(const LAS f32x4*)(GN + 32 * dvi + 8 * c4 + 4 * hi);
                u32x2 w; w.x = cvtpk_s(oacc[4 * c4] * rinv * gnv[0], oacc[4 * c4 + 1] * rinv * gnv[1]); w.y = cvtpk_s(oacc[4 * c4 + 2] * rinv * gnv[2], oacc[4 * c4 + 3] * rinv * gnv[3]);
                *(LAS u32x2*)(OT + trow * PQ + (32 * dvi + 8 * c4 + 4 * hi) * 2) = w;
            }
        }
#pragma unroll
        for (int c4 = 0; c4 < 4; ++c4) { const f32x4 gm = *(const LAS f32x4*)(GM + 32 * di + 8 * c4 + 4 * hi);
#pragma unroll
            for (int x = 0; x < 2; ++x)
#pragma unroll
                for (int j = 0; j < 4; ++j) SA[x][4 * c4 + j] *= gm[j]; }
        { bf16x8 af[4], bv[2][4];
#pragma unroll
          for (int ks = 0; ks < 4; ++ks) { af[ks] = *(const LAS bf16x8*)(KH + (32 * di + l32) * PK + (16 * ks + 8 * hi) * 2);
#pragma unroll
              for (int x = 0; x < 2; ++x) bv[x][ks] = *(const LAS bf16x8*)(VS + (32 * (dj0 + x) + l32) * PK + (16 * ks + 8 * hi) * 2); }
#pragma unroll
          for (int ks = 0; ks < 4; ++ks)
#pragma unroll
              for (int x = 0; x < 2; ++x) SA[x] = MFMA32(af[ks], bv[x][ks], SA[x]); }
#pragma unroll
        for (int x = 0; x < 2; ++x)
#pragma unroll
            for (int c4 = 0; c4 < 4; ++c4) { u32x2 w; w.x = cvtpk_s(SA[x][4 * c4], SA[x][4 * c4 + 1]); w.y = cvtpk_s(SA[x][4 * c4 + 2], SA[x][4 * c4 + 3]);
                *(LAS u32x2*)(ST + (32 * (dj0 + x) + l32) * PQ + (32 * di + 8 * c4 + 4 * hi) * 2) = w; }
    }
    LBAR();
    REC_WRITEOUT(31);
    LBAR();
#undef REC_WRITEOUT
}

#define ATTN_UNIT attn_mfma_unit
#define REC_UNIT rec_mfma_unit
__global__ void __launch_bounds__(512, 2) fwd_megakernel(Args a) {
    extern __shared__ __attribute__((aligned(16))) unsigned char lds_raw[];
    LAS unsigned char* lds = (LAS unsigned char*)lds_raw;
    cg::grid_group grid = cg::this_grid();
    const int G = gridDim.x, bx = blockIdx.x;
#define FRESH_TID() int tid_ = threadIdx.x; asm volatile("" : "+v"(tid_)); const int tid = tid_, lane = tid & 63, wave = __builtin_amdgcn_readfirstlane(tid >> 6); (void)lane; (void)wave
    unsigned char* ws = a.ws;
    float* ss0 = (float*)(ws + WS_SS); float* ss1 = ss0 + 4 * MTOK; float* ss2 = ss1 + 4 * MTOK; float* ss3 = ss2 + 4 * MTOK; float* ss4 = ss3 + 4 * MTOK;
    bf16_t* HB = (bf16_t*)(ws + WS_HB); bf16_t* PB = (bf16_t*)(ws + WS_PB); bf16_t* ATT = (bf16_t*)(ws + WS_ATT); bf16_t* REC = (bf16_t*)(ws + WS_REC);
    bf16_t* ACT = (bf16_t*)(ws + WS_ACT); bf16_t* MG = (bf16_t*)(ws + WS_MG); bf16_t* TPB = (bf16_t*)a.out;     bf16_t* H4B = (bf16_t*)(ws + WS_ATT);
    bf16_t* Qb = (bf16_t*)(ws + WS_Q); bf16_t* Kb = (bf16_t*)(ws + WS_K); bf16_t* VT = (bf16_t*)(ws + WS_VT); bf16_t* RQ = (bf16_t*)(ws + WS_RQ); bf16_t* RG = (bf16_t*)(ws + WS_RG);
    bf16_t* RIT = (bf16_t*)(ws + WS_RIT); bf16_t* SG = (bf16_t*)(ws + WS_SG); bf16_t* GA = (bf16_t*)(ws + WS_GA); bf16_t* GB = (bf16_t*)(ws + WS_GB);
    float* out = a.out;
    using pg8::Gemm; using pg8::StaticOrder; using pg8::gemm_phase;
    volatile LAS unsigned* MISC = (volatile LAS unsigned*)(lds + MISC_OFF);
    if (threadIdx.x < 32) MISC[threadIdx.x] = 0u;
    __syncthreads();
    const XcdBarrier xbar = xcd_barrier_post((unsigned*)(ws + WS_BAR), MISC + 8);

    { FRESH_TID(); p0_prologue(a, lds, tid, lane, wave, G); }
    grid.sync();

    { Gemm g{HB, (const bf16_t*)(ws + WS_W1IN), MTOK, 2 * DFF, DM}; StaticOrder S; S.init(MTOK, 2 * DFF, G, bx); pg8::EpiSwiglu E{ACT, ss0};
      gemm_phase<pg8::EpiSwiglu, StaticOrder, true, true>(lds, g, S, E); }
    xcd_barrier(xbar);
    { Gemm g{ACT, (const bf16_t*)(ws + WS_W1OUT), MTOK, DM, DFF}; StaticOrder S; S.init(MTOK, DM, G, bx); pg8::EpiRes<true> E{a.in[0], HB, ss1, 0.5f};
      gemm_phase<pg8::EpiRes<true>, StaticOrder, true, true>(lds, g, S, E); }
    xcd_barrier(xbar);
    { Gemm g{HB, (const bf16_t*)(ws + WS_WIN), MTOK, INW, DM}; StaticOrder S; S.init(MTOK, INW, G, bx); pg8::EpiWin E{ss1, a.in[3], Qb, Kb, VT, RQ, RG, RIT, SG, GA, GB};
      gemm_phase<pg8::EpiWin, StaticOrder, true, true>(lds, g, S, E); }
    xcd_barrier(xbar);
    {
        const int nrec = (G >= 256) ? 128 : G / 2;
        if (bx < nrec) { FRESH_TID(); for (int u = bx; u < NBATCH * 4; u += nrec) REC_UNIT(lds, u, RQ, RG, RIT, SG, a.in[10], REC, tid); }
        if (bx >= nrec) {
            const int na = G - nrec;
            { FRESH_TID();
            attn_mfma_units(lds, bx - nrec, na, NBATCH * 16 * 2, Qb, Kb, VT, a.in[2], a.in[9], ATT, tid); }
            Gemm g{PB, (const bf16_t*)(ws + WS_WP), MTOK, DM, PLE}; StaticOrder S; S.init(MTOK, DM, na, bx - nrec); pg8::EpiStoreBf16 E{TPB};
            gemm_phase<pg8::EpiStoreBf16, StaticOrder, true, true>(lds, g, S, E);
        }
    }
    xcd_barrier(xbar);
    { Gemm g{ATT, (const bf16_t*)(ws + WS_WATT), MTOK, DM, 512}; StaticOrder S; S.init(MTOK, DM, G, bx); pg8::EpiGate<false> E{GA, MG};
      gemm_phase<pg8::EpiGate<false>, StaticOrder, true, true>(lds, g, S, E); }
    { Gemm g{REC, (const bf16_t*)(ws + WS_WREC), MTOK, DM, 512}; StaticOrder S; S.init(MTOK, DM, G, bx); pg8::EpiGate<true> E{GB, MG};
      gemm_phase<pg8::EpiGate<true>, StaticOrder, true, true>(lds, g, S, E); }
    xcd_barrier(xbar);
    { Gemm g{MG, (const bf16_t*)(ws + WS_WOUT), MTOK, DM, DM}; StaticOrder S; S.init(MTOK, DM, G, bx); pg8::EpiRes<false> E{nullptr, HB, ss2, 1.0f};
      gemm_phase<pg8::EpiRes<false>, StaticOrder, true, true>(lds, g, S, E); }
    xcd_barrier(xbar);
    { Gemm g{HB, (const bf16_t*)(ws + WS_W2IN), MTOK, 2 * DFF, DM}; StaticOrder S; S.init(MTOK, 2 * DFF, G, bx); pg8::EpiSwiglu E{ACT, ss2};
      gemm_phase<pg8::EpiSwiglu, StaticOrder, true, true>(lds, g, S, E); }
    xcd_barrier(xbar);
    { Gemm g{ACT, (const bf16_t*)(ws + WS_W2OUT), MTOK, DM, DFF}; StaticOrder S; S.init(MTOK, DM, G, bx); pg8::EpiRes<false> E{nullptr, HB, ss3, 0.5f};
      gemm_phase<pg8::EpiRes<false>, StaticOrder, true, true>(lds, g, S, E); }
    xcd_barrier(xbar);
    { Gemm g{HB, (const bf16_t*)(ws + WS_WG), MTOK, DM, DM}; StaticOrder S; S.init(MTOK, DM, G, bx); pg8::EpiPle2 E{ss3, TPB, HB, H4B, ss4};
      gemm_phase<pg8::EpiPle2, StaticOrder, true, true>(lds, g, S, E); }
    xcd_barrier(xbar);
    {
        FRESH_TID();
        const int gw = bx * 8 + wave, NGW = G * 8;
        const f32x4* gf = (const f32x4*)a.in[20] + lane;
        f32x4 gv[4];
#pragma unroll
        for (int j = 0; j < 4; ++j) gv[j] = gf[64 * j];
        for (int m = gw; m < MTOK; m += 4 * NGW) {
            u32x2 w[4][4]; float rin[4];
#pragma unroll
            for (int q = 0; q < 4; ++q) { const int mq = (m + q * NGW < MTOK) ? m + q * NGW : m; const u32x2* hr = (const u32x2*)(H4B + (size_t)mq * DM) + lane;
                { const f32x4 q4 = *(const f32x4*)(ss4 + (size_t)mq * 4); rin[q] = (q4[0] + q4[1]) + (q4[2] + q4[3]); }
#pragma unroll
                for (int j = 0; j < 4; ++j) w[q][j] = hr[64 * j]; }
#pragma unroll
            for (int q = 0; q < 4; ++q) { const int mq = m + q * NGW;
                if (mq < MTOK) { const float rinv = __builtin_amdgcn_rsqf(rin[q] * (1.0f / 1024.0f) + 1e-6f); f32x4* xr = (f32x4*)(out + (size_t)mq * DM) + lane;
#pragma unroll
                    for (int j = 0; j < 4; ++j) { f32x4 v = (f32x4){bflo(w[q][j].x), bfhi(w[q][j].x), bflo(w[q][j].y), bfhi(w[q][j].y)}; v = v * rinv * gv[j]; xr[64 * j] = v; } } }
        }
    }
}

extern "C" void kernel_launch(void* const* d_in, const int* in_sizes, int n_in, void* d_out, int out_size, void* d_ws, size_t ws_size, hipStream_t stream) {
    static int grid = 0;
    if (grid == 0) {
        int dev = 0, cus = 0, per_cu = 0;
        (void)hipGetDevice(&dev);
        (void)hipDeviceGetAttribute(&cus, hipDeviceAttributeMultiprocessorCount, dev);
        (void)hipFuncSetAttribute((const void*)fwd_megakernel, hipFuncAttributeMaxDynamicSharedMemorySize, LDS_BYTES);
        if (hipOccupancyMaxActiveBlocksPerMultiprocessor(&per_cu, (const void*)fwd_megakernel, 512, LDS_BYTES) != hipSuccess || per_cu < 1) per_cu = 1;
        (void)hipGetLastError();
        if (cus <= 0) cus = 256;
        grid = cus * per_cu;
    }
    (void)hipMemsetAsync((unsigned char*)d_ws + WS_BAR, 0, XCD_BAR_WORDS * 4, stream);
    Args a{};
    for (int i = 0; i < 21; ++i) a.in[i] = (const float*)d_in[i];
    a.out = (float*)d_out; a.ws = (unsigned char*)d_ws;
    void* args[] = {&a};
    hipError_t e = hipLaunchCooperativeKernel((const void*)fwd_megakernel, dim3(grid), dim3(512), args, LDS_BYTES, stream);
    if (e != hipSuccess) fprintf(stderr, "cooperative launch failed: %s (grid %d)\n", hipGetErrorString(e), grid);
}
```

```cpp
#include <hip/hip_runtime.h>
#include <hip/hip_cooperative_groups.h>
#include <cstdio>
#include <cstdint>
namespace cg = cooperative_groups;
namespace pg8 {
#define PG8_LAS __attribute__((address_space(3)))
typedef unsigned short bf16_t;
typedef short bf16x8 __attribute__((ext_vector_type(8)));
typedef float f32x4 __attribute__((ext_vector_type(4)));
typedef unsigned u32x4 __attribute__((ext_vector_type(4)));
constexpr int BM = 256, BK = 64, HALF = 128, HTB = HALF * BK * 2  , STAGE_BYTES = 8 * HTB, NXCD = 8, WGM = 8;

__host__ __device__ __forceinline__ int lds_byte(int r, int c) { const int st = (r >> 4) * 2 + (c >> 5), rr = r & 15, cc = c & 31, ob = rr * 64 + cc * 2; return st * 1024 + (ob ^ (((ob >> 9) & 1) << 5)); }
__host__ __device__ __forceinline__ void stage_rc(int b, int& R, int& C) { const int st = b / 1024, sb = b % 1024, swz = sb ^ (((sb >> 9) & 1) << 5); R = (st >> 1) * 16 + swz / 64; C = (st & 1) * 32 + (swz % 64) / 2; }
__host__ __device__ __forceinline__ int perm32(int rho) { const int n = rho >> 4, i = rho & 15; return 8 * (i >> 2) + 4 * n + (i & 3); }

struct Unit { int pm, pn; };
struct Gemm { const bf16_t* A; const bf16_t* Bt; int M, N, K; };

struct StaticOrder {
    int nM, nN, nwg, G, c;
    __host__ __device__ void init(int M, int N, int G_, int c_) { nM = M / BM; nN = N / BM; nwg = nM * nN; G = G_; c = c_; }
    __host__ __device__ bool next(int i, Unit& u) const {
        const long L = (long)i * G + c; if (L >= nwg) return false;
        int wgid = (int)L; { const int q = nwg / NXCD, r = nwg % NXCD, xcd = wgid % NXCD, off = wgid / NXCD; wgid = (xcd < r ? xcd * (q + 1) : r * (q + 1) + (xcd - r) * q) + off; }
        const int nig = WGM * nN, gid = wgid / nig, fm = gid * WGM, gsz = (nM - fm) < WGM ? (nM - fm) : WGM;
        u.pm = fm + ((wgid % nig) % gsz); u.pn = (wgid % nig) / gsz; return true;
    }
    __device__ __forceinline__ void a_ready(const Unit&) const {}
    __device__ __forceinline__ void done(const Unit&) const {}
};

__device__ __forceinline__ unsigned cvt_pk_bf16(float lo, float hi) { unsigned r; asm volatile("v_cvt_pk_bf16_f32 %0, %1, %2" : "=v"(r) : "v"(lo), "v"(hi)); return r; }
typedef float f32x2 __attribute__((ext_vector_type(2)));
__device__ __forceinline__ float sigm(float x) { return __builtin_amdgcn_rcpf(1.0f + __builtin_amdgcn_exp2f(-1.44269504f * x)); }
__device__ __forceinline__ float bflo(unsigned w) { return __uint_as_float(w << 16); }
__device__ __forceinline__ float bfhi(unsigned w) { return __uint_as_float(w & 0xffff0000u); }
constexpr float RMS_EPS = 1e-6f;

struct EpiSwiglu {
    static constexpr bool PERM = true, AFTER_DRAIN = false, ROWSTAT = true;
    bf16_t* O; const float* ss;
    __device__ __forceinline__ void operator()(const f32x4 (&acc)[2][2][4][2], const Unit& u, int wr, int wc, int fr, int fq, const PG8_LAS float* rs, PG8_LAS float* xch, int tid) const {
        const int row0 = u.pm * BM + wr * 64 + fr, col0 = u.pn * 128 + wc * 32 + 8 * fq;
        float rv[2][4];
#pragma unroll
        for (int ai = 0; ai < 2; ++ai)
#pragma unroll
            for (int m = 0; m < 4; ++m) { const f32x4 q4 = *(const PG8_LAS f32x4*)(rs + (ai * HALF + wr * 64 + m * 16 + fr) * 4); rv[ai][m] = (q4[0] + q4[1]) + (q4[2] + q4[3]); }
#pragma unroll
        for (int ai = 0; ai < 2; ++ai)
#pragma unroll
            for (int m = 0; m < 4; ++m) {
                const int row = row0 + ai * HALF + m * 16;
                const float rinv = __builtin_amdgcn_rsqf(rv[ai][m] * (1.0f / 1024.0f) + RMS_EPS);
                const float nrl = -1.44269504f * rinv, rsq2 = rinv * rinv;
                unsigned ww[4];
#pragma unroll
                for (int n = 0; n < 2; ++n) {
                    const f32x4 ag = acc[ai][0][m][n], au = acc[ai][1][m][n];
                    const f32x4 t = ag * nrl;
                    f32x4 e; e[0] = __builtin_amdgcn_exp2f(t[0]); e[1] = __builtin_amdgcn_exp2f(t[1]); e[2] = __builtin_amdgcn_exp2f(t[2]); e[3] = __builtin_amdgcn_exp2f(t[3]);
                    const f32x4 d = e + 1.0f;
                    f32x4 r; r[0] = __builtin_amdgcn_rcpf(d[0]); r[1] = __builtin_amdgcn_rcpf(d[1]); r[2] = __builtin_amdgcn_rcpf(d[2]); r[3] = __builtin_amdgcn_rcpf(d[3]);
                    const f32x4 a = (ag * au) * (r * rsq2);
                    ww[2 * n] = cvt_pk_bf16(a[0], a[1]); ww[2 * n + 1] = cvt_pk_bf16(a[2], a[3]);
                }
                u32x4 w; w.x = ww[0]; w.y = ww[1]; w.z = ww[2]; w.w = ww[3];
                *(u32x4*)(O + (size_t)row * 2816 + col0) = w;
            }
    }
};

#define UNPK8(V_, lo4, hi4) do { const u32x4 v__ = (V_); lo4 = (f32x4){bflo(v__.x), bfhi(v__.x), bflo(v__.y), bfhi(v__.y)}; hi4 = (f32x4){bflo(v__.z), bfhi(v__.z), bflo(v__.w), bfhi(v__.w)}; } while (0)
#define SUMSQ8(a, b) (((a)[0] * (a)[0] + (a)[1] * (a)[1]) + ((a)[2] * (a)[2] + (a)[3] * (a)[3]) + ((b)[0] * (b)[0] + (b)[1] * (b)[1]) + ((b)[2] * (b)[2] + (b)[3] * (b)[3]))
template <bool BASE_F32> struct EpiRes {
    static constexpr bool PERM = true, AFTER_DRAIN = false, ROWSTAT = false;
    const float* base; bf16_t* hb; float* ssout; float alpha;
    __device__ __forceinline__ void operator()(const f32x4 (&acc)[2][2][4][2], const Unit& u, int wr, int wc, int fr, int fq, const PG8_LAS float* rs, PG8_LAS float* xch, int tid) const {
        const int row0 = u.pm * BM + wr * 64 + fr, col0 = u.pn * BM + wc * 32 + 8 * fq;
        if constexpr (!BASE_F32) {
            u32x4 pw[2][4][2];
#pragma unroll
            for (int ai = 0; ai < 2; ++ai)
#pragma unroll
                for (int m = 0; m < 4; ++m)
#pragma unroll
                    for (int bj = 0; bj < 2; ++bj) pw[ai][m][bj] = *(const u32x4*)(hb + (size_t)(row0 + ai * HALF + m * 16) * 1024 + col0 + bj * HALF);
#pragma unroll
            for (int ai = 0; ai < 2; ++ai)
#pragma unroll
                for (int m = 0; m < 4; ++m) {
                    const int row = row0 + ai * HALF + m * 16; float s = 0.f;
#pragma unroll
                    for (int bj = 0; bj < 2; ++bj) {
                        const size_t off = (size_t)row * 1024 + col0 + bj * HALF;
                        f32x4 b0, b1; UNPK8(pw[ai][m][bj], b0, b1);
                        const f32x4 o0 = b0 + acc[ai][bj][m][0] * alpha, o1 = b1 + acc[ai][bj][m][1] * alpha;
                        u32x4 w; w.x = cvt_pk_bf16(o0[0], o0[1]); w.y = cvt_pk_bf16(o0[2], o0[3]); w.z = cvt_pk_bf16(o1[0], o1[1]); w.w = cvt_pk_bf16(o1[2], o1[3]);
                        *(u32x4*)(hb + off) = w;
                        s += SUMSQ8(o0, o1);
                    }
                    s += __shfl_xor(s, 16); s += __shfl_xor(s, 32);
                    if (fq == 0) xch[(row - u.pm * BM) * 4 + wc] = s;
                }
        } else {
            f32x4 pb[2][2][2][2];
#define ER_LOAD(slot, g) do { _Pragma("unroll") for (int mm = 0; mm < 2; ++mm) _Pragma("unroll") for (int bj = 0; bj < 2; ++bj) { \
                const size_t off_ = (size_t)(row0 + ((g) >> 1) * HALF + (2 * ((g) & 1) + mm) * 16) * 1024 + col0 + bj * HALF; \
                pb[slot][mm][bj][0] = __builtin_nontemporal_load((const f32x4*)(base + off_)); pb[slot][mm][bj][1] = __builtin_nontemporal_load((const f32x4*)(base + off_ + 4)); } } while (0)
            ER_LOAD(0, 0);
#pragma unroll
            for (int g = 0; g < 4; ++g) {
                if (g + 1 < 4) ER_LOAD((g + 1) & 1, g + 1);
#pragma unroll
                for (int mm = 0; mm < 2; ++mm) {
                    const int ai = g >> 1, m = 2 * (g & 1) + mm; const int row = row0 + ai * HALF + m * 16; float s = 0.f;
#pragma unroll
                    for (int bj = 0; bj < 2; ++bj) {
                        const size_t off = (size_t)row * 1024 + col0 + bj * HALF;
                        const f32x4 o0 = pb[g & 1][mm][bj][0] + acc[ai][bj][m][0] * alpha, o1 = pb[g & 1][mm][bj][1] + acc[ai][bj][m][1] * alpha;
                        u32x4 w; w.x = cvt_pk_bf16(o0[0], o0[1]); w.y = cvt_pk_bf16(o0[2], o0[3]); w.z = cvt_pk_bf16(o1[0], o1[1]); w.w = cvt_pk_bf16(o1[2], o1[3]);
                        *(u32x4*)(hb + off) = w;
                        s += SUMSQ8(o0, o1);
                    }
                    s += __shfl_xor(s, 16); s += __shfl_xor(s, 32);
                    if (fq == 0) xch[(row - u.pm * BM) * 4 + wc] = s;
                }
            }
#undef ER_LOAD
        }
        asm volatile("s_waitcnt lgkmcnt(0)\n\ts_barrier" ::: "memory");
        if (tid < BM) { const f32x4 q4 = *(const PG8_LAS f32x4*)(xch + tid * 4); ssout[((size_t)u.pm * BM + tid) * 4 + u.pn] = (q4[0] + q4[1]) + (q4[2] + q4[3]); }
    }
};

struct EpiWin {
    static constexpr bool PERM = true, AFTER_DRAIN = false, ROWSTAT = true;
    const float* ss; const float* lbp; bf16_t *Q, *Kb, *VT, *RQ, *RG, *RIT, *SG, *GA, *GB;
    __device__ __forceinline__ void operator()(const f32x4 (&acc)[2][2][4][2], const Unit& u, int wr, int wc, int fr, int fq, const PG8_LAS float* rs, PG8_LAS float* xch, int tid) const {
        const int pn = u.pn, row0 = u.pm * BM + wr * 64 + fr, cl = wc * 32 + 8 * fq;
        int kind = 0; float scale = 1.f; bf16_t* dst = Q; int pitch = 512, cbase = 0; int trw = 0;
        if (pn < 2) { dst = Q; cbase = pn * 256; scale = 0.125f; }
        else if (pn == 2) { dst = Kb; pitch = 128; cbase = 0; }
        else if (pn < 5) { dst = RQ; cbase = (pn - 3) * 256; }
        else if (pn < 7) { dst = RG; cbase = (pn - 5) * 256; kind = 1; }
        else if (pn < 9) { dst = RIT; cbase = (pn - 7) * 256; trw = 512; }
        else if (pn < 11) { dst = SG; cbase = (pn - 9) * 256; kind = 2; }
        else if (pn < 15) { dst = GA; pitch = 1024; cbase = (pn - 11) * 256; kind = 2; }
        else { dst = GB; pitch = 1024; cbase = (pn - 15) * 256; kind = 2; }
        f32x4 lb[2][2];
#pragma unroll
        for (int bj = 0; bj < 2; ++bj)
#pragma unroll
            for (int n = 0; n < 2; ++n) lb[bj][n] = (f32x4){0.f, 0.f, 0.f, 0.f};
        if (kind == 1) {
#pragma unroll
            for (int bj = 0; bj < 2; ++bj)
#pragma unroll
                for (int n = 0; n < 2; ++n) {
                    const int c = cbase + bj * HALF + cl + 4 * n;
                    const f32x4 p0 = *(const f32x4*)(lbp + c), p1 = *(const f32x4*)(lbp + 512 + c);
#pragma unroll
                    for (int j = 0; j < 4; ++j) lb[bj][n][j] = sigm(p0[j] - p1[j]);
                }
        }
        float rv[2][4];
#pragma unroll
        for (int ai = 0; ai < 2; ++ai)
#pragma unroll
            for (int m = 0; m < 4; ++m) { const f32x4 q4 = *(const PG8_LAS f32x4*)(rs + (ai * HALF + wr * 64 + m * 16 + fr) * 4); rv[ai][m] = (q4[0] + q4[1]) + (q4[2] + q4[3]); }
#pragma unroll
        for (int ai = 0; ai < 2; ++ai)
#pragma unroll
            for (int m = 0; m < 4; ++m) {
                const int row = row0 + ai * HALF + m * 16;
                const float rinv = __builtin_amdgcn_rsqf(rv[ai][m] * (1.0f / 1024.0f) + RMS_EPS);
#pragma unroll
                for (int bj = 0; bj < 2; ++bj) {
                    f32x4 v[2];
#pragma unroll
                    for (int n = 0; n < 2; ++n) {
                        v[n] = acc[ai][bj][m][n] * rinv;
                        if (kind == 0) v[n] = v[n] * scale;
                        else {
#pragma unroll
                            for (int j = 0; j < 4; ++j) v[n][j] = sigm(v[n][j]);
                            if (kind == 1) {
#pragma unroll
                                for (int j = 0; j < 4; ++j) v[n][j] = __builtin_amdgcn_logf(lb[bj][n][j] + (1.0f - lb[bj][n][j]) * v[n][j]) * 0.69314718056f;
                            }
                        }
                    }
                    const bool tr = (trw != 0) || (pn == 2 && bj == 1);
                    if (!tr) {
                        u32x4 w; w.x = cvt_pk_bf16(v[0][0], v[0][1]); w.y = cvt_pk_bf16(v[0][2], v[0][3]); w.z = cvt_pk_bf16(v[1][0], v[1][1]); w.w = cvt_pk_bf16(v[1][2], v[1][3]);
                        *(u32x4*)(dst + (size_t)row * pitch + cbase + bj * HALF + cl) = w;
                    } else {
                        bf16_t* tb = (pn == 2) ? VT : RIT; const int cw = (pn == 2) ? 128 : 512; const int c0 = (pn == 2) ? cl : cbase + bj * HALF + cl;
                        bf16_t* p = tb + (((size_t)((row >> 11) * cw + c0)) << 11) + (row & 2047);
#pragma unroll
                        for (int n = 0; n < 2; ++n)
#pragma unroll
                            for (int j = 0; j < 4; ++j) p[(size_t)(4 * n + j) << 11] = (bf16_t)(cvt_pk_bf16(v[n][j], v[n][j]) & 0xffffu);
                    }
                }
            }
    }
};

template <bool ADD> struct EpiGate {
    static constexpr bool PERM = true, AFTER_DRAIN = false, ROWSTAT = false;
    const bf16_t* gate; bf16_t* MG;
    __device__ __forceinline__ void operator()(const f32x4 (&acc)[2][2][4][2], const Unit& u, int wr, int wc, int fr, int fq, const PG8_LAS float* rs, PG8_LAS float* xch, int tid) const {
        const int row0 = u.pm * BM + wr * 64 + fr, col0 = u.pn * BM + wc * 32 + 8 * fq;
        u32x4 gwb[2][2][2], pwb[2][2][2];
#define EG_LOAD(slot, g) do { _Pragma("unroll") for (int mm = 0; mm < 2; ++mm) _Pragma("unroll") for (int bj = 0; bj < 2; ++bj) { \
            const size_t off_ = (size_t)(row0 + ((g) >> 1) * HALF + (2 * ((g) & 1) + mm) * 16) * 1024 + col0 + bj * HALF; \
            gwb[slot][mm][bj] = *(const u32x4*)(gate + off_); if (ADD) pwb[slot][mm][bj] = *(const u32x4*)(MG + off_); } } while (0)
        EG_LOAD(0, 0);
#pragma unroll
        for (int g = 0; g < 4; ++g) {
            if (g + 1 < 4) EG_LOAD((g + 1) & 1, g + 1);
#pragma unroll
            for (int mm = 0; mm < 2; ++mm) {
                const int ai = g >> 1, m = 2 * (g & 1) + mm; const int row = row0 + ai * HALF + m * 16;
#pragma unroll
                for (int bj = 0; bj < 2; ++bj) {
                    const size_t off = (size_t)row * 1024 + col0 + bj * HALF;
                    f32x4 g0, g1; UNPK8(gwb[g & 1][mm][bj], g0, g1);
                    f32x4 o0 = g0 * acc[ai][bj][m][0], o1 = g1 * acc[ai][bj][m][1];
                    if (ADD) { f32x4 p0, p1; UNPK8(pwb[g & 1][mm][bj], p0, p1); o0 += p0; o1 += p1; }
                    u32x4 w; w.x = cvt_pk_bf16(o0[0], o0[1]); w.y = cvt_pk_bf16(o0[2], o0[3]); w.z = cvt_pk_bf16(o1[0], o1[1]); w.w = cvt_pk_bf16(o1[2], o1[3]);
                    *(u32x4*)(MG + off) = w;
                }
            }
        }
#undef EG_LOAD
    }
};

struct EpiStoreBf16 {
    static constexpr bool PERM = true, AFTER_DRAIN = false, ROWSTAT = false;
    bf16_t* T;
    __device__ __forceinline__ void operator()(const f32x4 (&acc)[2][2][4][2], const Unit& u, int wr, int wc, int fr, int fq, const PG8_LAS float* rs, PG8_LAS float* xch, int tid) const {
        const int row0 = u.pm * BM + wr * 64 + fr, col0 = u.pn * BM + wc * 32 + 8 * fq;
#pragma unroll
        for (int ai = 0; ai < 2; ++ai)
#pragma unroll
            for (int m = 0; m < 4; ++m) {
                const int row = row0 + ai * HALF + m * 16;
#pragma unroll
                for (int bj = 0; bj < 2; ++bj) {
                    const size_t off = (size_t)row * 1024 + col0 + bj * HALF;
                    const f32x4 a0 = acc[ai][bj][m][0], a1 = acc[ai][bj][m][1];
                    u32x4 w; w.x = cvt_pk_bf16(a0[0], a0[1]); w.y = cvt_pk_bf16(a0[2], a0[3]); w.z = cvt_pk_bf16(a1[0], a1[1]); w.w = cvt_pk_bf16(a1[2], a1[3]);
                    *(u32x4*)(T + off) = w;
                }
            }
    }
};

struct EpiPle2 {
    static constexpr bool PERM = true, AFTER_DRAIN = false, ROWSTAT = true;
    const float* ss; const bf16_t* T; const bf16_t* h3b; bf16_t* h4b; float* ssout;
    __device__ __forceinline__ void operator()(const f32x4 (&acc)[2][2][4][2], const Unit& u, int wr, int wc, int fr, int fq, const PG8_LAS float* rs, PG8_LAS float* xch, int tid) const {
        const int row0 = u.pm * BM + wr * 64 + fr, col0 = u.pn * BM + wc * 32 + 8 * fq;
        float rv[2][4];
#pragma unroll
        for (int ai = 0; ai < 2; ++ai)
#pragma unroll
            for (int m = 0; m < 4; ++m) { const f32x4 q4 = *(const PG8_LAS f32x4*)(rs + (ai * HALF + wr * 64 + m * 16 + fr) * 4); rv[ai][m] = (q4[0] + q4[1]) + (q4[2] + q4[3]); }
        u32x4 hwb[2][2], twb[2][2];
#define EP_LOAD(slot, g) do { _Pragma("unroll") for (int bj = 0; bj < 2; ++bj) { \
            const size_t off_ = (size_t)(row0 + ((g) >> 2) * HALF + ((g) & 3) * 16) * 1024 + col0 + bj * HALF; \
            hwb[slot][bj] = *(const u32x4*)(h3b + off_); twb[slot][bj] = *(const u32x4*)(T + off_); } } while (0)
        EP_LOAD(0, 0);
#pragma unroll
        for (int g = 0; g < 8; ++g) {
            if (g + 1 < 8) EP_LOAD((g + 1) & 1, g + 1);
            {
                const int ai = g >> 2, m = g & 3; const int row = row0 + ai * HALF + m * 16; float s = 0.f;
                const float rinv = __builtin_amdgcn_rsqf(rv[ai][m] * (1.0f / 1024.0f) + RMS_EPS);
#pragma unroll
                for (int bj = 0; bj < 2; ++bj) {
                    const size_t off = (size_t)row * 1024 + col0 + bj * HALF;
                    f32x4 b0, b1, t0, t1; UNPK8(hwb[g & 1][bj], b0, b1); UNPK8(twb[g & 1][bj], t0, t1);
                    f32x4 o0, o1;
#pragma unroll
                    for (int j = 0; j < 4; ++j) { o0[j] = b0[j] + sigm(acc[ai][bj][m][0][j] * rinv) * t0[j]; o1[j] = b1[j] + sigm(acc[ai][bj][m][1][j] * rinv) * t1[j]; }
                    u32x4 w; w.x = cvt_pk_bf16(o0[0], o0[1]); w.y = cvt_pk_bf16(o0[2], o0[3]); w.z = cvt_pk_bf16(o1[0], o1[1]); w.w = cvt_pk_bf16(o1[2], o1[3]);
                    *(u32x4*)(h4b + off) = w;
                    s += SUMSQ8(o0, o1);
                }
                s += __shfl_xor(s, 16); s += __shfl_xor(s, 32);
                if (fq == 0) xch[(row - u.pm * BM) * 4 + wc] = s;
            }
        }
#undef EP_LOAD
        asm volatile("s_waitcnt lgkmcnt(0)\n\ts_barrier" ::: "memory");
        if (tid < BM) { const f32x4 q4 = *(const PG8_LAS f32x4*)(xch + tid * 4); ssout[((size_t)u.pm * BM + tid) * 4 + u.pn] = (q4[0] + q4[1]) + (q4[2] + q4[3]); }
    }
};

template <class Epi, class Sched, bool ALIGN_EPI = false, bool SP2 = false>
__device__ __forceinline__ void gemm_phase(PG8_LAS unsigned char* lds, const Gemm g, const Sched& S, const Epi& E) {
    int tid_ = threadIdx.x; asm volatile("" : "+v"(tid_));
    const int tid = tid_, wid = __builtin_amdgcn_readfirstlane(tid >> 6), lane = tid & 63, wr = wid >> 2, wc = wid & 3, fr = lane & 15, fq = lane >> 4;
    const int K = g.K, nt = K / BK;
    unsigned voffA[2], voffB[2];
#pragma unroll
    for (int i = 0; i < 2; ++i) { int R, C; stage_rc(tid * 16 + i * 8192, R, C); const int Rb = Epi::PERM ? ((R & ~31) + perm32(R & 31)) : R;
        voffA[i] = (unsigned)(R * K + C) * 2u; voffB[i] = (unsigned)(Rb * K + C) * 2u; }
    const size_t kstep = (size_t)(BK * 2);
    const size_t hstep = (size_t)HALF * K * 2;
    const size_t tstep = 2 * hstep;
    const unsigned ldsw = (unsigned)wid * 1024u;
    const int aoff = lds_byte(wr * 64 + fr, fq * 8), boff = lds_byte(wc * 32 + fr, fq * 8);
#define PG8_SA(b, h) (((b) * 2 + (h)) * HTB)
#define PG8_SB(b, h) ((4 + (b) * 2 + (h)) * HTB)
#define PG8_STAGE(bufoff, gbase, voff) do { _Pragma("unroll") for (int _i = 0; _i < 2; ++_i) \
        __builtin_amdgcn_global_load_lds((const unsigned*)((const char*)(gbase) + (voff)[_i]), (PG8_LAS unsigned*)(lds + (bufoff) + ldsw + _i * 8192), 16, 0, 0); } while (0)
#define PG8_LDA(dst, b, h) do { _Pragma("unroll") for (int m = 0; m < 4; ++m) _Pragma("unroll") for (int k = 0; k < 2; ++k) dst[m][k] = *(const PG8_LAS bf16x8*)(lds + PG8_SA(b, h) + aoff + m * 2048 + k * 1024); } while (0)
#define PG8_LDB(dst, b, h) do { _Pragma("unroll") for (int n = 0; n < 2; ++n) _Pragma("unroll") for (int k = 0; k < 2; ++k) dst[n][k] = *(const PG8_LAS bf16x8*)(lds + PG8_SB(b, h) + boff + n * 2048 + k * 1024); } while (0)
#define PG8_MMA(ai, bj, At, Bt) do { __builtin_amdgcn_s_setprio(1); _Pragma("unroll") for (int m = 0; m < 4; ++m) _Pragma("unroll") for (int n = 0; n < 2; ++n) _Pragma("unroll") for (int k = 0; k < 2; ++k) \
        acc[ai][bj][m][n] = __builtin_amdgcn_mfma_f32_16x16x32_bf16(Bt[n][k], At[m][k], acc[ai][bj][m][n], 0, 0, 0); __builtin_amdgcn_s_setprio(0); } while (0)
#define PG8_WAIT_V(n) asm volatile("s_waitcnt vmcnt(" #n ")" ::: "memory")
#define PG8_WAIT_L(n) asm volatile("s_waitcnt lgkmcnt(" #n ")" ::: "memory")
#define PG8_BAR __builtin_amdgcn_s_barrier()
#define PG8_SCHED __builtin_amdgcn_sched_barrier(0)
    Unit cur, nxt; int ui = 0;
    if (!S.next(0, cur)) return;
#define PG8_ROWSTAT_DMA(unit_, ui_) do { if constexpr (Epi::ROWSTAT) { if (wid < 4) { unsigned keep_; const float* gp_ = E.ss + ((size_t)(unit_).pm * BM + wid * 64 + lane) * 4; \
        const unsigned dst_ = (unsigned)__builtin_amdgcn_readfirstlane((int)((unsigned)(size_t)lds + 133120u + (unsigned)((ui_) & 1) * 4096u + (unsigned)wid * 1024u)); \
        asm volatile("s_mov_b32 %0, m0\n\ts_mov_b32 m0, %2\n\ts_nop 0\n\tglobal_load_lds_dwordx4 %1, off\n\ts_mov_b32 m0, %0" : "=&s"(keep_) : "v"(gp_), "s"(dst_) : "memory"); } } } while (0)
    PG8_ROWSTAT_DMA(cur, 0);
    f32x4 acc[2][2][4][2];
#pragma unroll
    for (int a = 0; a < 2; ++a)
#pragma unroll
        for (int b = 0; b < 2; ++b)
#pragma unroll
            for (int m = 0; m < 4; ++m)
#pragma unroll
                for (int n = 0; n < 2; ++n) acc[a][b][m][n] = (f32x4){0.f, 0.f, 0.f, 0.f};
    bf16x8 At[4][2], B0[2][2], B1[2][2];
    const char* cA = (const char*)g.A + (size_t)cur.pm * tstep; const char* cB = (const char*)g.Bt + (size_t)cur.pn * tstep;
    S.a_ready(cur);
    if constexpr (SP2) {
        PG8_STAGE(PG8_SB(0, 0), cB, voffB); PG8_STAGE(PG8_SB(0, 1), cB + hstep, voffB); PG8_STAGE(PG8_SA(0, 0), cA, voffA); PG8_STAGE(PG8_SA(0, 1), cA + hstep, voffA);
        if (wr == 1) PG8_BAR;
        PG8_WAIT_V(2); PG8_BAR;
        PG8_STAGE(PG8_SB(1, 0), cB + kstep, voffB); PG8_STAGE(PG8_SA(1, 0), cA + kstep, voffA); PG8_STAGE(PG8_SB(1, 1), cB + hstep + kstep, voffB);
        PG8_WAIT_V(6); PG8_BAR;
    } else {
        PG8_STAGE(PG8_SB(0, 0), cB, voffB); PG8_STAGE(PG8_SA(0, 0), cA, voffA); PG8_STAGE(PG8_SB(0, 1), cB + hstep, voffB); PG8_STAGE(PG8_SA(0, 1), cA + hstep, voffA);
        if (wr == 1) PG8_BAR;
        PG8_WAIT_V(4); PG8_BAR;
        PG8_STAGE(PG8_SB(1, 0), cB + kstep, voffB); PG8_STAGE(PG8_SA(1, 0), cA + kstep, voffA); PG8_STAGE(PG8_SB(1, 1), cB + hstep + kstep, voffB);
        PG8_WAIT_V(6); PG8_BAR;
    }
    for (;;) {
        const bool has_next = S.next(ui + 1, nxt);
        const char* nA = has_next ? (const char*)g.A + (size_t)nxt.pm * tstep : cA; const char* nB = has_next ? (const char*)g.Bt + (size_t)nxt.pn * tstep : cB;
        for (int t = 0; t < nt; t += 2) {
            const bool last = (t == nt - 2);
            const char* a1 = cA + (size_t)(t + 1) * kstep;
            const char* a2 = last ? nA : cA + (size_t)(t + 2) * kstep; const char* b2 = last ? nB : cB + (size_t)(t + 2) * kstep;
            const char* a3 = a2 + kstep; const char* b3 = b2 + kstep;
            if (last && has_next) S.a_ready(nxt);
            if constexpr (SP2) {
            PG8_LDB(B0, 0, 0); PG8_LDB(B1, 0, 1); PG8_SCHED; PG8_LDA(At, 0, 0); PG8_STAGE(PG8_SA(1, 1), a1 + hstep, voffA);
            PG8_WAIT_V(8); PG8_WAIT_L(0); PG8_BAR; PG8_MMA(0, 0, At, B0); PG8_MMA(0, 1, At, B1); PG8_BAR; PG8_SCHED;
            PG8_LDA(At, 0, 1); PG8_STAGE(PG8_SB(0, 0), b2, voffB); PG8_STAGE(PG8_SB(0, 1), b2 + hstep, voffB); PG8_STAGE(PG8_SA(0, 0), a2, voffA);
            PG8_WAIT_V(8); PG8_WAIT_L(0); PG8_BAR; PG8_MMA(1, 0, At, B0); PG8_MMA(1, 1, At, B1); PG8_BAR; PG8_SCHED;
            PG8_LDB(B0, 1, 0); PG8_LDB(B1, 1, 1); PG8_SCHED; PG8_LDA(At, 1, 0); PG8_STAGE(PG8_SA(0, 1), a2 + hstep, voffA);
            PG8_WAIT_V(8); PG8_WAIT_L(0); PG8_BAR; PG8_MMA(0, 0, At, B0); PG8_MMA(0, 1, At, B1); PG8_BAR; PG8_SCHED;
            PG8_LDA(At, 1, 1); PG8_STAGE(PG8_SB(1, 0), b3, voffB); PG8_STAGE(PG8_SB(1, 1), b3 + hstep, voffB); PG8_STAGE(PG8_SA(1, 0), a3, voffA);
            PG8_WAIT_V(8); PG8_WAIT_L(0); PG8_BAR; PG8_MMA(1, 0, At, B0); PG8_MMA(1, 1, At, B1); PG8_BAR; PG8_SCHED;
            } else {
            PG8_LDB(B0, 0, 0); PG8_SCHED; PG8_LDA(At, 0, 0); PG8_STAGE(PG8_SA(1, 1), a1 + hstep, voffA);
            PG8_WAIT_L(8); PG8_BAR; PG8_WAIT_L(0); PG8_MMA(0, 0, At, B0); PG8_BAR; PG8_SCHED;
            PG8_LDB(B1, 0, 1); PG8_STAGE(PG8_SB(0, 0), b2, voffB);
            PG8_BAR; PG8_WAIT_L(0); PG8_MMA(0, 1, At, B1); PG8_BAR;
            PG8_LDA(At, 0, 1); PG8_STAGE(PG8_SA(0, 0), a2, voffA);
            PG8_BAR; PG8_WAIT_L(0); PG8_MMA(1, 0, At, B0); PG8_BAR; PG8_SCHED;
            PG8_STAGE(PG8_SB(0, 1), b2 + hstep, voffB);
            PG8_WAIT_V(6); PG8_BAR; PG8_MMA(1, 1, At, B1); PG8_BAR;
            PG8_LDB(B0, 1, 0); PG8_SCHED; PG8_LDA(At, 1, 0); PG8_STAGE(PG8_SA(0, 1), a2 + hstep, voffA);
            PG8_WAIT_L(8); PG8_BAR; PG8_WAIT_L(0); PG8_MMA(0, 0, At, B0); PG8_BAR; PG8_SCHED;
            PG8_LDB(B1, 1, 1); PG8_STAGE(PG8_SB(1, 0), b3, voffB);
            PG8_BAR; PG8_WAIT_L(0); PG8_MMA(0, 1, At, B1); PG8_BAR;
            PG8_LDA(At, 1, 1); PG8_STAGE(PG8_SA(1, 0), a3, voffA);
            PG8_BAR; PG8_WAIT_L(0); PG8_MMA(1, 0, At, B0); PG8_BAR; PG8_SCHED;
            PG8_STAGE(PG8_SB(1, 1), b3 + hstep, voffB);
            PG8_WAIT_V(6); PG8_BAR; PG8_MMA(1, 1, At, B1); PG8_BAR;
            }
        }
        if constexpr (ALIGN_EPI) { if (wr == 0) PG8_BAR; }
        if constexpr (!Epi::AFTER_DRAIN) { int t2_ = threadIdx.x; asm volatile("" : "+v"(t2_)); const int l2_ = t2_ & 63, w2_ = __builtin_amdgcn_readfirstlane(t2_ >> 6);
            E(acc, cur, w2_ >> 2, w2_ & 3, l2_ & 15, l2_ >> 4, (const PG8_LAS float*)(lds + 133120 + (ui & 1) * 4096), (PG8_LAS float*)(lds + 141312), t2_); S.done(cur); }
        if (!has_next) break;
#pragma unroll
        for (int a = 0; a < 2; ++a)
#pragma unroll
            for (int b = 0; b < 2; ++b)
#pragma unroll
                for (int m = 0; m < 4; ++m)
#pragma unroll
                    for (int n = 0; n < 2; ++n) acc[a][b][m][n] = (f32x4){0.f, 0.f, 0.f, 0.f};
        cur = nxt; cA = nA; cB = nB; ++ui;
        if constexpr (ALIGN_EPI) { if (wr == 1) PG8_BAR; }
        PG8_ROWSTAT_DMA(cur, ui);
    }
    PG8_WAIT_V(0);
    if constexpr (!ALIGN_EPI) { if (wr == 0) PG8_BAR; }
    PG8_BAR;
    if constexpr (Epi::AFTER_DRAIN) { E.fused(acc, cur, wr, wc, fr, fq, lds, wid, lane); S.done(cur); }
#undef PG8_SA
#undef PG8_SB
#undef PG8_STAGE
#undef PG8_LDA
#undef PG8_LDB
#undef PG8_MMA
#undef PG8_WAIT_V
#undef PG8_WAIT_L
#undef PG8_BAR
#undef PG8_SCHED
#undef PG8_ROWSTAT_DMA
}
}

constexpr int MTOK = 65536, DM = 1024, DFF = 2816, SEQL = 2048, NBATCH = 32, INW = 4864, PLE = 256;
constexpr int STAGGER_US = 2;
constexpr int LDS_BYTES = 147456;
#define LAS __attribute__((address_space(3)))
typedef unsigned short bf16_t;
typedef float f32x4 __attribute__((ext_vector_type(4)));
typedef unsigned u32x4 __attribute__((ext_vector_type(4)));
typedef unsigned u32x2 __attribute__((ext_vector_type(2)));

constexpr size_t MiB = 1u << 20;
constexpr size_t WS_SS = 948 * MiB;
constexpr size_t WS_BAR = 1536 * 1024;
constexpr int MISC_OFF = 132096;
constexpr size_t WS_W1IN = 2 * MiB;
constexpr size_t WS_W1OUT = WS_W1IN + (size_t)5632 * 1024 * 2;
constexpr size_t WS_WIN = WS_W1OUT + (size_t)1024 * 2816 * 2;
constexpr size_t WS_WATT = WS_WIN + (size_t)4864 * 1024 * 2;
constexpr size_t WS_WREC = WS_WATT + (size_t)1024 * 512 * 2;
constexpr size_t WS_WOUT = WS_WREC + (size_t)1024 * 512 * 2;
constexpr size_t WS_W2IN = WS_WOUT + (size_t)1024 * 1024 * 2;
constexpr size_t WS_W2OUT = WS_W2IN + (size_t)5632 * 1024 * 2;
constexpr size_t WS_WG = WS_W2OUT + (size_t)1024 * 2816 * 2;
constexpr size_t WS_WP = WS_WG + (size_t)1024 * 1024 * 2;
constexpr size_t WS_WEND = WS_WP + (size_t)1024 * 256 * 2;
static_assert(WS_WEND <= 52 * MiB, "weights");
constexpr size_t WS_HB = 52 * MiB;
constexpr size_t WS_PB = WS_HB + 128 * MiB;
constexpr size_t WS_ATT = WS_PB + 32 * MiB;
constexpr size_t WS_REC = WS_ATT + 64 * MiB;
constexpr size_t WS_A = WS_REC + 64 * MiB;
constexpr size_t WS_Q = WS_A;
constexpr size_t WS_K = WS_Q + 64 * MiB;
constexpr size_t WS_VT = WS_K + 16 * MiB;
constexpr size_t WS_RQ = WS_VT + 16 * MiB;
constexpr size_t WS_RG = WS_RQ + 64 * MiB;
constexpr size_t WS_RIT = WS_RG + 64 * MiB;
constexpr size_t WS_SG = WS_RIT + 64 * MiB;
constexpr size_t WS_GA = WS_SG + 64 * MiB;
constexpr size_t WS_GB = WS_GA + 128 * MiB;
constexpr size_t WS_END = WS_GB + 128 * MiB;
constexpr size_t WS_ACT = WS_A;
constexpr size_t WS_MG = WS_A;
constexpr size_t WS_T = WS_A;
static_assert(WS_END <= 948 * MiB && WS_SS + (size_t)5 * MTOK * 16 <= 1024 * MiB, "d_ws map");

__device__ __forceinline__ float bf2f(unsigned short b) { return __uint_as_float((unsigned)b << 16); }
__device__ __forceinline__ float bflo(unsigned w) { return __uint_as_float(w << 16); }
__device__ __forceinline__ float bfhi(unsigned w) { return __uint_as_float(w & 0xffff0000u); }
__device__ __forceinline__ unsigned pk2(float lo, float hi) { return pg8::cvt_pk_bf16(lo, hi); }
#define LDS_WAIT() asm volatile("s_waitcnt lgkmcnt(0)" ::: "memory")

__constant__ unsigned char T5_BUCKET[128] = {0, 1, 2, 3, 4, 5, 6, 7, 8, 9, 10, 11, 12, 13, 14, 15, 16, 16, 16, 17, 17, 18, 18, 18, 19, 19, 19, 20, 20, 20, 20, 21, 21, 21, 21, 22, 22, 22, 22, 22, 23, 23, 23, 23, 23, 23, 24, 24, 24, 24, 24, 24, 25, 25, 25, 25, 25, 25, 25, 26, 26, 26, 26, 26, 26, 26, 26, 27, 27, 27, 27, 27, 27, 27, 27, 27, 27, 28, 28, 28, 28, 28, 28, 28, 28, 28, 28, 29, 29, 29, 29, 29, 29, 29, 29, 29, 29, 29, 29, 30, 30, 30, 30, 30, 30, 30, 30, 30, 30, 30, 30, 30, 30, 31, 31, 31, 31, 31, 31, 31, 31, 31, 31, 31, 31, 31, 31, 31};

__device__ __forceinline__ void p0_transpose_item(const float* W, int K, int N, bf16_t* WT, const float* gain, int swz, LAS float* scr, int item, int lane) {
    const int nblk = N / 32, kb = item / nblk, nb = item % nblk, k0 = 64 * kb, n0 = 32 * nb;
    int drow0 = n0;
    if (swz) { const int up = n0 >= DFF ? 1 : 0; const int j = n0 - up * DFF; drow0 = 256 * (j >> 7) + (j & 127) + 128 * up; }
#pragma unroll
    for (int i = 0; i < 32; ++i) { const int kk = 2 * i + (lane >> 5); const float g = gain ? gain[k0 + kk] : 1.0f; scr[kk * 33 + (lane & 31)] = __builtin_nontemporal_load(W + (size_t)(k0 + kk) * N + n0 + (lane & 31)) * g; }
    LDS_WAIT(); asm volatile("" ::: "memory");
    const int c = lane & 7;
#pragma unroll
    for (int j = 0; j < 4; ++j) { const int n = (lane >> 3) + 8 * j; const LAS float* s = scr + (8 * c) * 33 + n;
        u32x4 o; o.x = pk2(s[0 * 33], s[1 * 33]); o.y = pk2(s[2 * 33], s[3 * 33]); o.z = pk2(s[4 * 33], s[5 * 33]); o.w = pk2(s[6 * 33], s[7 * 33]);
        *(u32x4*)(WT + (size_t)(drow0 + n) * K + k0 + 8 * c) = o; }
    LDS_WAIT(); asm volatile("" ::: "memory");
}

struct Args { const float* in[21]; float* out; unsigned char* ws; };

__device__ __forceinline__ void p0_prologue(const Args& a, LAS unsigned char* lds, int tid, int lane, int wave, int G) {
    unsigned char* ws = a.ws;
    LAS float* scr = (LAS float*)(lds + wave * 16384);
    const int gw = blockIdx.x * 8 + wave, NGW = G * 8;
    constexpr int I1 = 16 * 176, I2 = 44 * 32, I3 = 16 * 152, I4 = 8 * 32, I6 = 16 * 32, I10 = 4 * 32;
    constexpr int NITEMS = I1 + I2 + I3 + I4 + I4 + I6 + I1 + I2 + I6 + I10;
    float* ss = (float*)(ws + WS_SS);
    bf16_t* HB = (bf16_t*)(ws + WS_HB);
    for (int pass = 0; pass < 2; ++pass) {
    if ((pass ^ (wave & 1)) == 0) {
    for (int it = gw; it < NITEMS; it += NGW) {
        int r = it;
        if (r < I1) { p0_transpose_item(a.in[5], 1024, 5632, (bf16_t*)(ws + WS_W1IN), a.in[4], 1, scr, r, lane); continue; } r -= I1;
        if (r < I2) { p0_transpose_item(a.in[6], 2816, 1024, (bf16_t*)(ws + WS_W1OUT), nullptr, 0, scr, r, lane); continue; } r -= I2;
        if (r < I3) { p0_transpose_item(a.in[8], 1024, 4864, (bf16_t*)(ws + WS_WIN), a.in[7], 0, scr, r, lane); continue; } r -= I3;
        if (r < I4) { p0_transpose_item(a.in[11], 512, 1024, (bf16_t*)(ws + WS_WATT), nullptr, 0, scr, r, lane); continue; } r -= I4;
        if (r < I4) { p0_transpose_item(a.in[12], 512, 1024, (bf16_t*)(ws + WS_WREC), nullptr, 0, scr, r, lane); continue; } r -= I4;
        if (r < I6) { p0_transpose_item(a.in[13], 1024, 1024, (bf16_t*)(ws + WS_WOUT), nullptr, 0, scr, r, lane); continue; } r -= I6;
        if (r < I1) { p0_transpose_item(a.in[15], 1024, 5632, (bf16_t*)(ws + WS_W2IN), a.in[14], 1, scr, r, lane); continue; } r -= I1;
        if (r < I2) { p0_transpose_item(a.in[16], 2816, 1024, (bf16_t*)(ws + WS_W2OUT), nullptr, 0, scr, r, lane); continue; } r -= I2;
        if (r < I6) { p0_transpose_item(a.in[18], 1024, 1024, (bf16_t*)(ws + WS_WG), a.in[17], 0, scr, r, lane); continue; } r -= I6;
        p0_transpose_item(a.in[19], 256, 1024, (bf16_t*)(ws + WS_WP), nullptr, 0, scr, r, lane);
    }
    } else {
    for (int m = gw; m < MTOK; m += 4 * NGW) {
        f32x4 v[4][4]; float s[4];
#pragma unroll
        for (int q = 0; q < 4; ++q) { const int mq = (m + q * NGW < MTOK) ? m + q * NGW : m; const f32x4* xr = (const f32x4*)(a.in[0] + (size_t)mq * DM) + lane;
#pragma unroll
            for (int j = 0; j < 4; ++j) v[q][j] = __builtin_nontemporal_load(xr + 64 * j); }
#pragma unroll
        for (int q = 0; q < 4; ++q) { s[q] = 0.f;
#pragma unroll
            for (int j = 0; j < 4; ++j) s[q] += (v[q][j].x * v[q][j].x + v[q][j].y * v[q][j].y) + (v[q][j].z * v[q][j].z + v[q][j].w * v[q][j].w); }
#pragma unroll
        for (int o = 1; o < 64; o <<= 1) {
#pragma unroll
            for (int q = 0; q < 4; ++q) s[q] += __shfl_xor(s[q], o); }
#pragma unroll
        for (int q = 0; q < 4; ++q) { const int mq = m + q * NGW;
            if (mq < MTOK) { u32x2* o8 = (u32x2*)(HB + (size_t)mq * DM) + lane;
#pragma unroll
                for (int j = 0; j < 4; ++j) { u32x2 w; w.x = pk2(v[q][j].x, v[q][j].y); w.y = pk2(v[q][j].z, v[q][j].w); o8[64 * j] = w; }
                if (lane == 0) *(f32x4*)(ss + (size_t)mq * 4) = (f32x4){s[q], 0.f, 0.f, 0.f}; } }
    }
    }
    }
    const int gt = blockIdx.x * 512 + tid, NGT = G * 512;
    bf16_t* PB = (bf16_t*)(ws + WS_PB);
    for (int i = gt; i < MTOK * PLE / 8; i += 4 * NGT) {
        f32x4 p0[4], p1[4];
#pragma unroll
        for (int q = 0; q < 4; ++q) { const int iq = (i + q * NGT < MTOK * PLE / 8) ? i + q * NGT : i; p0[q] = __builtin_nontemporal_load((const f32x4*)a.in[1] + 2 * iq); p1[q] = __builtin_nontemporal_load((const f32x4*)a.in[1] + 2 * iq + 1); }
#pragma unroll
        for (int q = 0; q < 4; ++q) { const int iq = i + q * NGT;
            if (iq < MTOK * PLE / 8) { u32x4 w; w.x = pk2(p0[q].x, p0[q].y); w.y = pk2(p0[q].z, p0[q].w); w.z = pk2(p1[q].x, p1[q].y); w.w = pk2(p1[q].z, p1[q].w); ((u32x4*)PB)[iq] = w; } }
    }
}


struct PartOrder {
    pg8::StaticOrder S; int pm0;
    __device__ void init(int Mpart, int N, int G, int c, int pm0_) { S.init(Mpart, N, G, c); pm0 = pm0_; }
    __device__ bool next(int i, pg8::Unit& u) const { const bool r = S.next(i, u); u.pm += pm0; return r; }
    __device__ __forceinline__ void a_ready(const pg8::Unit&) const {}
    __device__ __forceinline__ void done(const pg8::Unit&) const {}
};

struct RevOrder {
    pg8::StaticOrder S; int nr;
    __device__ void init(int M, int N, int G, int c) { S.init(M, N, G, c); nr = (S.nwg + G - 1) / G; }
    __device__ bool next(int i, pg8::Unit& u) const { if (i >= nr) return false; return S.next(nr - 1 - i, u); }
    __device__ __forceinline__ void a_ready(const pg8::Unit&) const {}
    __device__ __forceinline__ void done(const pg8::Unit&) const {}
};
#define XB_TMO      128
#define XB_XCNT(j)  (256  + 64 * (j))
#define XB_XSUB(j)  (1280 + 64 * (j))
#define XB_XGEN(j)  (2304 + 64 * (j))
#define XB_TOP      3328
#define XB_TOPGEN   3392
#define XCD_BAR_WORDS 3456
#define XB_SPIN_CAP (1u << 18)

__device__ __forceinline__ unsigned xb_ld(unsigned* p)              { return __hip_atomic_load(p, __ATOMIC_RELAXED, __HIP_MEMORY_SCOPE_AGENT); }
__device__ __forceinline__ unsigned xb_add(unsigned* p, unsigned v) { return __hip_atomic_fetch_add(p, v, __ATOMIC_RELAXED, __HIP_MEMORY_SCOPE_AGENT); }
__device__ __forceinline__ unsigned xb_xcc_id() { return (unsigned)__builtin_amdgcn_s_getreg((3 << 11) | 20) & 0xFu; }
#define XB_SPIN(cond, bar) do { unsigned _sp = 0; while (cond) { __builtin_amdgcn_s_sleep(1); \
    if ((++_sp & 255u) == 0u) { if (xb_ld(&(bar)[XB_TMO])) break; if (_sp > XB_SPIN_CAP) { atomicAdd(&(bar)[XB_TMO], 1u); break; } } } } while (0)

struct XcdBarrier {
    unsigned* bar; unsigned x;
    volatile LAS unsigned* st;
};

__device__ __forceinline__ XcdBarrier xcd_barrier_post(unsigned* bar, volatile LAS unsigned* st) {
    XcdBarrier b; b.bar = bar; b.x = xb_xcc_id(); b.st = st;
    if (threadIdx.x == 0) (void)xb_add(&bar[XB_XCNT(b.x)], 1u);
    return b;
}
__device__ __forceinline__ void xcd_barrier_complete(unsigned* bar, unsigned x, unsigned& nloc, unsigned& nx) {
    const unsigned G = gridDim.x * gridDim.y * gridDim.z;
    unsigned sum, cnt, mine, sp = 0u;
    for (;;) {
        sum = 0u; cnt = 0u; mine = 0u;
#pragma unroll
        for (unsigned j = 0; j < 16; ++j) { const unsigned c = xb_ld(&bar[XB_XCNT(j)]); sum += c; cnt += (c > 0u) ? 1u : 0u; mine = (j == x) ? c : mine; }
        if (sum == G) break;
        __builtin_amdgcn_s_sleep(1);
        if ((++sp & 255u) == 0u) { if (xb_ld(&bar[XB_TMO])) break; if (sp > XB_SPIN_CAP) { atomicAdd(&bar[XB_TMO], 1u); break; } }
    }
    nloc = mine > 0u ? mine : 1u; nx = cnt > 0u ? cnt : 1u;
}

__device__ __forceinline__ void xcd_barrier(const XcdBarrier& b) {
    asm volatile("s_waitcnt vmcnt(0)" ::: "memory");
    __syncthreads();
    if (threadIdx.x == 0) {
        unsigned* bar = b.bar;
        __builtin_amdgcn_s_waitcnt(0);
        unsigned nloc = b.st[0], nx = b.st[1];
        if (nloc == 0u) { xcd_barrier_complete(bar, b.x, nloc, nx); b.st[0] = nloc; b.st[1] = nx; }
        const unsigned old = xb_add(&bar[XB_XSUB(b.x)], 1u);
        const unsigned gen = old / nloc;
        if (old + 1u == (gen + 1u) * nloc) {
            __builtin_amdgcn_fence(__ATOMIC_RELEASE, "agent");
            asm volatile("s_waitcnt vmcnt(0)" ::: "memory");
            const unsigned og = xb_add(&bar[XB_TOP], 1u);
            const unsigned tg = og / nx;
            if (og + 1u == (tg + 1u) * nx) xb_add(&bar[XB_TOPGEN], 1u);
            else XB_SPIN(xb_ld(&bar[XB_TOPGEN]) == tg, bar);
            __builtin_amdgcn_fence(__ATOMIC_ACQUIRE, "agent");
            xb_add(&bar[XB_XGEN(b.x)], 1u);
            asm volatile("s_waitcnt vmcnt(0)" ::: "memory");
        } else {
            XB_SPIN(xb_ld(&bar[XB_XGEN(b.x)]) == gen, bar);
            __builtin_amdgcn_fence(__ATOMIC_ACQUIRE, "agent");
            asm volatile("s_waitcnt vmcnt(0)" ::: "memory");
        }
    }
    __syncthreads();
}

__device__ __forceinline__ void xcd_group_barrier(const XcdBarrier& b) {
    asm volatile("s_waitcnt vmcnt(0)" ::: "memory");
    __syncthreads();
    if (threadIdx.x == 0) {
        unsigned* bar = b.bar;
        __builtin_amdgcn_s_waitcnt(0);
        unsigned nloc = b.st[0], nx = b.st[1];
        if (nloc == 0u) { xcd_barrier_complete(bar, b.x, nloc, nx); b.st[0] = nloc; b.st[1] = nx; }
        const unsigned old = xb_add(&bar[XB_XSUB(b.x)], 1u);
        const unsigned gen = old / nloc;
        if (old + 1u == (gen + 1u) * nloc) xb_add(&bar[XB_XGEN(b.x)], 1u);
        else XB_SPIN(xb_ld(&bar[XB_XGEN(b.x)]) == gen, bar);
        __builtin_amdgcn_fence(__ATOMIC_ACQUIRE, "agent");
        asm volatile("s_waitcnt vmcnt(0)" ::: "memory");
    }
    __syncthreads();
}
typedef short bf16x8 __attribute__((ext_vector_type(8)));
typedef float f32x16 __attribute__((ext_vector_type(16)));
typedef float f32x2_t __attribute__((ext_vector_type(2)));
typedef __bf16 bf16x2_t __attribute__((ext_vector_type(2)));
__device__ __forceinline__ unsigned cvtpk_s(float lo, float hi) { f32x2_t v = {lo, hi}; bf16x2_t b = __builtin_convertvector(v, bf16x2_t); return __builtin_bit_cast(unsigned, b); }
__device__ __forceinline__ float ex(float x) { return __builtin_amdgcn_exp2f(x * 1.44269504f); }
#define LBAR() asm volatile("s_waitcnt lgkmcnt(0)\n\ts_barrier" ::: "memory")
#define MFMA32(a, b, c) __builtin_amdgcn_mfma_f32_32x32x16_bf16((a), (b), (c), 0, 0, 0)
__device__ __forceinline__ int crow(int r, int hi) { return (r & 3) + 8 * (r >> 2) + 4 * hi; }
__device__ __forceinline__ bf16x8 pack8(const f32x16& x, int s) {
    u32x4 p; p.x = cvtpk_s(x[8 * s], x[8 * s + 1]); p.y = cvtpk_s(x[8 * s + 2], x[8 * s + 3]); p.z = cvtpk_s(x[8 * s + 4], x[8 * s + 5]); p.w = cvtpk_s(x[8 * s + 6], x[8 * s + 7]);
    return __builtin_bit_cast(bf16x8, p);
}
__device__ __forceinline__ bf16x8 ld2x8(const LAS unsigned char* p) {
    const u32x2 lo = *(const LAS u32x2*)p, hi = *(const LAS u32x2*)(p + 16);
    u32x4 v; v.x = lo.x; v.y = lo.y; v.z = hi.x; v.w = hi.y; return __builtin_bit_cast(bf16x8, v);
}

__device__ __forceinline__ void attn_mfma_units(LAS unsigned char* lds, int u0, int ustride, int nunits, const bf16_t* Q, const bf16_t* Kb, const bf16_t* VT, const float* relb, const float* sinks, bf16_t* ATT, int tid) {
    constexpr int KP = 144, VP = 520;
    constexpr float LOG2E = 1.44269504f;
    LAS unsigned char* Ks = lds; LAS unsigned char* Vs = lds + 256 * KP; LAS float* ext = (LAS float*)(lds + 256 * KP + 64 * VP);
    const int lane = tid & 63, wv = tid >> 6, g = wv >> 1, l32 = lane & 31, hi = lane >> 5;
    const int skey = tid >> 1, shalf = tid & 1, sd = tid >> 3, sseg = tid & 7;
    u32x4 kw[4], vw[4];
#define AT_LOAD(u_) do { const int b_ = (u_) >> 5, n_ = ((u_) >> 1) & 15, hk_ = (u_) & 1; \
        const int kpos_ = n_ * 128 - 128 + skey, vpos_ = n_ * 128 - 128 + sseg * 32; \
        const u32x4* ks_ = (const u32x4*)(Kb + (size_t)(b_ * SEQL + (kpos_ < 0 ? 0 : kpos_)) * 128 + hk_ * 64 + shalf * 32); \
        const u32x4* vs_ = (const u32x4*)(VT + ((size_t)((b_ * 2 + hk_) * 64 + sd) << 11) + (vpos_ < 0 ? 0 : vpos_)); \
        _Pragma("unroll") for (int i = 0; i < 4; ++i) { kw[i] = ks_[i]; vw[i] = vs_[i]; } \
        if (kpos_ < 0) { _Pragma("unroll") for (int i = 0; i < 4; ++i) kw[i] = (u32x4){0u, 0u, 0u, 0u}; } \
        if (vpos_ < 0) { _Pragma("unroll") for (int i = 0; i < 4; ++i) vw[i] = (u32x4){0u, 0u, 0u, 0u}; } } while (0)
    if (u0 < nunits) AT_LOAD(u0);
    for (int unit = u0; unit < nunits; unit += ustride) {
        const int b = unit >> 5, n = (unit >> 1) & 15, hk = unit & 1, head = hk * 4 + g;
        {   LAS u32x4* d = (LAS u32x4*)(Ks + skey * KP + shalf * 64);
#pragma unroll
            for (int i = 0; i < 4; ++i) d[i] = kw[i];
            LAS u32x2* dd = (LAS u32x2*)(Vs + sd * VP + sseg * 64);
#pragma unroll
            for (int i = 0; i < 4; ++i) { u32x2 a; a.x = vw[i].x; a.y = vw[i].y; u32x2 c; c.x = vw[i].z; c.y = vw[i].w; dd[2 * i] = a; dd[2 * i + 1] = c; }
            for (int i = tid; i < 4 * 192; i += 512) { const int gg = i / 192, dist = i % 192 - 32;
                ext[i] = (dist >= 0 && dist < 128) ? relb[(int)T5_BUCKET[dist & 127] * 8 + hk * 4 + gg] * LOG2E : -INFINITY; }
        }
        bf16x8 qc[2][4];
#pragma unroll
        for (int sb = 0; sb < 2; ++sb) { const size_t row_ = (size_t)b * SEQL + n * 128 + 32 * (2 * (wv & 1) + sb) + l32;
#pragma unroll
            for (int ds = 0; ds < 4; ++ds) qc[sb][ds] = *(const bf16x8*)(Q + row_ * 512 + head * 64 + 16 * ds + 8 * hi); }
        LBAR();
        if (unit + ustride < nunits) AT_LOAD(unit + ustride);
        const float sink = sinks[head] * LOG2E;
        const LAS float* ex0 = ext + g * 192 + l32 - 4 * hi;
#pragma unroll
        for (int sb = 0; sb < 2; ++sb) {
            const int a = 2 * (wv & 1) + sb;
            const size_t row = (size_t)b * SEQL + n * 128 + 32 * a + l32;
            f32x16 S[5];
            {   bf16x8 kfr[2][4];
#pragma unroll
                for (int ds = 0; ds < 4; ++ds) kfr[0][ds] = *(const LAS bf16x8*)(Ks + (32 * a + l32) * KP + (16 * ds + 8 * hi) * 2);
#pragma unroll
                for (int t = 0; t < 5; ++t) {
                    if (t + 1 < 5) {
#pragma unroll
                        for (int ds = 0; ds < 4; ++ds) kfr[(t + 1) & 1][ds] = *(const LAS bf16x8*)(Ks + (32 * (a + t + 1) + l32) * KP + (16 * ds + 8 * hi) * 2);
                    }
                    f32x16 acc;
#pragma unroll
                    for (int r = 0; r < 16; ++r) acc[r] = 0.f;
#pragma unroll
                    for (int ds = 0; ds < 4; ++ds) acc = MFMA32(kfr[t & 1][ds], qc[sb][ds], acc);
                    S[t] = acc;
                }
            }
            float mx = sink;
#pragma unroll
            for (int t = 0; t < 5; ++t) {
                const bool dead = (n == 0) && (a + t < 4);
#pragma unroll
                for (int r = 0; r < 16; ++r) {
                    float sv = __builtin_fmaf(S[t][r], LOG2E, ex0[160 - 32 * t - (r & 3) - 8 * (r >> 2)]);
                    sv = dead ? -INFINITY : sv;
                    S[t][r] = sv; mx = fmaxf(mx, sv);
                }
            }
            mx = fmaxf(mx, __shfl_xor(mx, 32));
            float l = 0.f;
#pragma unroll
            for (int t = 0; t < 5; ++t)
#pragma unroll
                for (int r = 0; r < 16; ++r) { const float p = __builtin_amdgcn_exp2f(S[t][r] - mx); S[t][r] = p; l += p; }
            l += __shfl_xor(l, 32); l += __builtin_amdgcn_exp2f(sink - mx);
            f32x16 O[2];
#pragma unroll
            for (int dt = 0; dt < 2; ++dt)
#pragma unroll
                for (int r = 0; r < 16; ++r) O[dt][r] = 0.f;
            {   bf16x8 vfr[2][4];
#pragma unroll
                for (int i = 0; i < 4; ++i) vfr[0][i] = ld2x8(Vs + (l32 + 32 * (i & 1)) * VP + (32 * a + 16 * (i >> 1) + 4 * hi) * 2);
#pragma unroll
                for (int t = 0; t < 5; ++t) {
                    if (t + 1 < 5) {
#pragma unroll
                        for (int i = 0; i < 4; ++i) vfr[(t + 1) & 1][i] = ld2x8(Vs + (l32 + 32 * (i & 1)) * VP + (32 * (a + t + 1) + 16 * (i >> 1) + 4 * hi) * 2);
                    }
#pragma unroll
                    for (int kb = 0; kb < 2; ++kb) {
                        const bf16x8 pf = pack8(S[t], kb);
#pragma unroll
                        for (int dt = 0; dt < 2; ++dt) O[dt] = MFMA32(vfr[t & 1][2 * kb + dt], pf, O[dt]);
                    }
                }
            }
            const float rl = 1.0f / l;
#pragma unroll
            for (int dt = 0; dt < 2; ++dt)
#pragma unroll
                for (int c4 = 0; c4 < 4; ++c4) {
                    u32x2 w; w.x = cvtpk_s(O[dt][4 * c4] * rl, O[dt][4 * c4 + 1] * rl); w.y = cvtpk_s(O[dt][4 * c4 + 2] * rl, O[dt][4 * c4 + 3] * rl);
                    *(u32x2*)(ATT + row * 512 + head * 64 + 32 * dt + 8 * c4 + 4 * hi) = w;
                }
            asm volatile("" ::: "memory");
        }
        LBAR();
    }
#undef AT_LOAD
}

__device__ __forceinline__ void rec_mfma_unit(LAS unsigned char* lds, int unit, const bf16_t* RQ, const bf16_t* RG, const bf16_t* RIT, const bf16_t* SG, const float* recnorm, bf16_t* REC, int tid) {
    constexpr int PQ = 272, PK = 144;
    LAS unsigned char* QT = lds;
    LAS unsigned char* KT = lds + 17408;
    LAS unsigned char* KH = lds + 34816;
    LAS unsigned char* VS = lds + 53248;
    LAS unsigned char* ST = lds + 71680;
    LAS float* GM = (LAS float*)(lds + 106496);
    LAS float* SEG = (LAS float*)(lds + 107008);
    LAS float* PSS = (LAS float*)(lds + 111104);
    LAS float* GN = (LAS float*)(lds + 129536);
    LAS unsigned char* OT = lds + 112128;
    const int b = unit >> 2, h = unit & 3;
    const int lane = tid & 63, wv = tid >> 6, l32 = lane & 31, hi = lane >> 5;
    const size_t R0 = (size_t)b * SEQL;
    const int cp = lane, tseg = wv;
    const bf16_t* gsrc = RG + (R0 + 8 * tseg) * 512 + h * 128 + 2 * cp;
    const bf16_t* qsrc = RQ + (R0 + 8 * tseg) * 512 + h * 128 + 2 * cp;
    const int vdv = tid >> 2, vpart = tid & 3;
    const bf16_t* vsrc = RIT + (((size_t)((b * 4 + h) * 128 + vdv)) << 11) + vpart * 16;
    const int dvi = wv >> 1, tj = ((wv >> 2) ^ wv) & 1;
    const int di = wv >> 1, dj0 = 2 * (wv & 1);
    const int trow = 32 * tj + l32;
    const int wt = tid >> 3, wp = tid & 7;
    const size_t woff = (R0 + wt) * 512 + h * 128 + wp * 16;
    f32x16 SA[2];
#pragma unroll
    for (int x = 0; x < 2; ++x)
#pragma unroll
        for (int r = 0; r < 16; ++r) SA[x][r] = 0.f;
    if (tid < 128) GN[tid] = recnorm[tid];
    unsigned gw[8], qw[8]; u32x4 vw[2]; u32x4 sgw[2];
    sgw[0] = (u32x4){0u, 0u, 0u, 0u}; sgw[1] = sgw[0];
#pragma unroll
    for (int tt = 0; tt < 8; ++tt) { gw[tt] = *(const unsigned*)(gsrc + tt * 512); qw[tt] = *(const unsigned*)(qsrc + tt * 512); }
    vw[0] = *(const u32x4*)(vsrc); vw[1] = *(const u32x4*)(vsrc + 8);
#define REC_WRITEOUT(cc) do { const LAS u32x4* op_ = (const LAS u32x4*)(OT + wt * PQ + wp * 32); \
        _Pragma("unroll") for (int i_ = 0; i_ < 2; ++i_) { const u32x4 ov_ = op_[i_]; f32x4 a0_, a1_, s0_, s1_; \
            a0_ = (f32x4){bflo(ov_.x), bfhi(ov_.x), bflo(ov_.y), bfhi(ov_.y)}; a1_ = (f32x4){bflo(ov_.z), bfhi(ov_.z), bflo(ov_.w), bfhi(ov_.w)}; \
            s0_ = (f32x4){bflo(sgw[i_].x), bfhi(sgw[i_].x), bflo(sgw[i_].y), bfhi(sgw[i_].y)}; s1_ = (f32x4){bflo(sgw[i_].z), bfhi(sgw[i_].z), bflo(sgw[i_].w), bfhi(sgw[i_].w)}; \
            a0_ = a0_ * s0_; a1_ = a1_ * s1_; u32x4 w_; w_.x = cvtpk_s(a0_[0], a0_[1]); w_.y = cvtpk_s(a0_[2], a0_[3]); w_.z = cvtpk_s(a1_[0], a1_[1]); w_.w = cvtpk_s(a1_[2], a1_[3]); \
            *(u32x4*)(REC + woff + (size_t)(cc) * 64 * 512 + 8 * i_) = w_; } } while (0)
    for (int c = 0; c < 32; ++c) {
        f32x2_t fv[8], cpv[8]; f32x2_t run = {1.f, 1.f};
#pragma unroll
        for (int tt = 0; tt < 8; ++tt) { fv[tt].x = ex(bflo(gw[tt])); fv[tt].y = ex(bfhi(gw[tt])); run = run * fv[tt]; cpv[tt] = run; }
        *(LAS f32x2_t*)(SEG + tseg * 128 + 2 * cp) = run;
        LBAR();
        if (c > 0) REC_WRITEOUT(c - 1);
        f32x2_t pre = {1.f, 1.f}, tot = {1.f, 1.f};
#pragma unroll
        for (int s = 0; s < 8; ++s) { const f32x2_t v = *(const LAS f32x2_t*)(SEG + s * 128 + 2 * cp); tot = tot * v; if (s < tseg) pre = pre * v; }
        f32x2_t kh[8];
#pragma unroll
        for (int tt = 0; tt < 8; ++tt) {
            const f32x2_t E = pre * cpv[tt];
            f32x2_t rE; rE.x = fminf(__builtin_amdgcn_rcpf(E.x), 5.5e34f); rE.y = fminf(__builtin_amdgcn_rcpf(E.y), 5.5e34f);
            const f32x2_t k = 1.0f - fv[tt];
            f32x2_t qv; qv.x = bflo(qw[tt]); qv.y = bfhi(qw[tt]);
            const f32x2_t qt = qv * E, kt = k * rE;
            kh[tt] = k * (tot * rE);
            *(LAS unsigned*)(QT + (8 * tseg + tt) * PQ + 4 * cp) = cvtpk_s(qt.x, qt.y);
            *(LAS unsigned*)(KT + (8 * tseg + tt) * PQ + 4 * cp) = cvtpk_s(kt.x, kt.y);
        }
        { u32x4 w0, w1; w0.x = cvtpk_s(kh[0].x, kh[1].x); w0.y = cvtpk_s(kh[2].x, kh[3].x); w0.z = cvtpk_s(kh[4].x, kh[5].x); w0.w = cvtpk_s(kh[6].x, kh[7].x);
          w1.x = cvtpk_s(kh[0].y, kh[1].y); w1.y = cvtpk_s(kh[2].y, kh[3].y); w1.z = cvtpk_s(kh[4].y, kh[5].y); w1.w = cvtpk_s(kh[6].y, kh[7].y);
          *(LAS u32x4*)(KH + (2 * cp) * PK + 16 * tseg) = w0; *(LAS u32x4*)(KH + (2 * cp + 1) * PK + 16 * tseg) = w1; }
        if (tseg == 0) *(LAS f32x2_t*)(GM + 2 * cp) = tot;
        *(LAS u32x4*)(VS + vdv * PK + vpart * 32) = vw[0]; *(LAS u32x4*)(VS + vdv * PK + vpart * 32 + 16) = vw[1];
        LBAR();
        if (c + 1 < 32) {
            const size_t adv = (size_t)(c + 1) * 64;
#pragma unroll
            for (int tt = 0; tt < 8; ++tt) { gw[tt] = *(const unsigned*)(gsrc + (adv + tt) * 512); qw[tt] = *(const unsigned*)(qsrc + (adv + tt) * 512); }
            vw[0] = *(const u32x4*)(vsrc + adv); vw[1] = *(const u32x4*)(vsrc + adv + 8);
        }
        sgw[0] = *(const u32x4*)(SG + woff + (size_t)c * 64 * 512); sgw[1] = *(const u32x4*)(SG + woff + (size_t)c * 64 * 512 + 8);
        bf16x8 qf[8], kf[8];
#pragma unroll
        for (int ks = 0; ks < 8; ++ks) qf[ks] = *(const LAS bf16x8*)(QT + trow * PQ + (16 * ks + 8 * hi) * 2);
#pragma unroll
        for (int ks = 0; ks < 8; ++ks) kf[ks] = *(const LAS bf16x8*)(KT + l32 * PQ + (16 * ks + 8 * hi) * 2);
        bf16x8 vf[2];
#pragma unroll
        for (int kb = 0; kb < 2; ++kb) vf[kb] = ld2x8(VS + (32 * dvi + l32) * PK + (16 * kb + 4 * hi) * 2);
        f32x16 at0, at1;
#pragma unroll
        for (int r = 0; r < 16; ++r) { at0[r] = 0.f; at1[r] = 0.f; }
#pragma unroll
        for (int ks = 0; ks < 8; ++ks) at0 = MFMA32(kf[ks], qf[ks], at0);
        if (tj) {
#pragma unroll
            for (int ks = 0; ks < 8; ++ks) kf[ks] = *(const LAS bf16x8*)(KT + (32 + l32) * PQ + (16 * ks + 8 * hi) * 2);
#pragma unroll
            for (int ks = 0; ks < 8; ++ks) at1 = MFMA32(kf[ks], qf[ks], at1);
#pragma unroll
            for (int r = 0; r < 16; ++r) at1[r] = (crow(r, hi) <= l32) ? at1[r] : 0.f;
        } else {
#pragma unroll
            for (int r = 0; r < 16; ++r) at0[r] = (crow(r, hi) <= l32) ? at0[r] : 0.f;
        }
        if (c > 0) {
#pragma unroll
            for (int ks = 0; ks < 8; ++ks) kf[ks] = *(const LAS bf16x8*)(ST + (32 * dvi + l32) * PQ + (16 * ks + 8 * hi) * 2);
        }
        f32x16 oacc;
#pragma unroll
        for (int r = 0; r < 16; ++r) oacc[r] = 0.f;
#pragma unroll
        for (int kb = 0; kb < 2; ++kb) { const bf16x8 pf = pack8(at0, kb); oacc = MFMA32(vf[kb], pf, oacc); }
        if (tj) {
            bf16x8 vg[2];
#pragma unroll
            for (int kb = 0; kb < 2; ++kb) vg[kb] = ld2x8(VS + (32 * dvi + l32) * PK + (32 + 16 * kb + 4 * hi) * 2);
#pragma unroll
            for (int kb = 0; kb < 2; ++kb) { const bf16x8 pf = pack8(at1, kb); oacc = MFMA32(vg[kb], pf, oacc); }
        }
        if (c > 0) {
#pragma unroll
            for (int ks = 0; ks < 8; ++ks) oacc = MFMA32(kf[ks], qf[ks], oacc);
        }
        { float ps = 0.f;
#pragma unroll
          for (int r = 0; r < 16; ++r) ps += oacc[r] * oacc[r];
          ps += __shfl_xor(ps, 32);
          if (hi == 0) PSS[dvi * 64 + trow] = ps; }
        LBAR();
        {   const float tot2 = (PSS[trow] + PSS[64 + trow]) + (PSS[128 + trow] + PSS[192 + trow]);
            const float rinv = __builtin_amdgcn_rsqf(tot2 * (1.0f / 128.0f) + 1e-6f);
#pragma unroll
            for (int c4 = 0; c4 < 4; ++c4) {
                const f32x4 gnv = *(const LAS f32x4*)(GN + 32 * dvi + 8 * c4 + 4 * hi);
                u32x2 w; w.x = cvtpk_s(oacc[4 * c4] * rinv * gnv[0], oacc[4 * c4 + 1] * rinv * gnv[1]); w.y = cvtpk_s(oacc[4 * c4 + 2] * rinv * gnv[2], oacc[4 * c4 + 3] * rinv * gnv[3]);
                *(LAS u32x2*)(OT + trow * PQ + (32 * dvi + 8 * c4 + 4 * hi) * 2) = w;
            }
        }
#pragma unroll
        for (int c4 = 0; c4 < 4; ++c4) { const f32x4 gm = *(const LAS f32x4*)(GM + 32 * di + 8 * c4 + 4 * hi);
#pragma unroll
            for (int x = 0; x < 2; ++x)
#pragma unroll
                for (int j = 0; j < 4; ++j) SA[x][4 * c4 + j] *= gm[j]; }
        { bf16x8 af[4], bv[2][4];
#pragma unroll
          for (int ks = 0; ks < 4; ++ks) { af[ks] = *(const LAS bf16x8*)(KH + (32 * di + l32) * PK + (16 * ks + 8 * hi) * 2);
#pragma unroll
              for (int x = 0; x < 2; ++x) bv[x][ks] = *(const LAS bf16x8*)(VS + (32 * (dj0 + x) + l32) * PK + (16 * ks + 8 * hi) * 2); }
#pragma unroll
          for (int ks = 0; ks < 4; ++ks)
#pragma unroll
              for (int x = 0; x < 2; ++x) SA[x] = MFMA32(af[ks], bv[x][ks], SA[x]); }
#pragma unroll
        for (int x = 0; x < 2; ++x)
#pragma unroll
            for (int c4 = 0; c4 < 4; ++c4) { u32x2 w; w.x = cvtpk_s(SA[x][4 * c4], SA[x][4 * c4 + 1]); w.y = cvtpk_s(SA[x][4 * c4 + 2], SA[x][4 * c4 + 3]);
                *(LAS u32x2*)(ST + (32 * (dj0 + x) + l32) * PQ + (32 * di + 8 * c4 + 4 * hi) * 2) = w; }
    }
    LBAR();
    REC_WRITEOUT(31);
    LBAR();
#undef REC_WRITEOUT
}

#define ATTN_UNIT attn_mfma_unit
#define REC_UNIT rec_mfma_unit
__global__ void __launch_bounds__(512, 2) fwd_megakernel(Args a) {
    extern __shared__ __attribute__((aligned(16))) unsigned char lds_raw[];
    LAS unsigned char* lds = (LAS unsigned char*)lds_raw;
    cg::grid_group grid = cg::this_grid();
    const int G = gridDim.x, bx = blockIdx.x;
#define FRESH_TID() int tid_ = threadIdx.x; asm volatile("" : "+v"(tid_)); const int tid = tid_, lane = tid & 63, wave = __builtin_amdgcn_readfirstlane(tid >> 6); (void)lane; (void)wave
    unsigned char* ws = a.ws;
    float* ss0 = (float*)(ws + WS_SS); float* ss1 = ss0 + 4 * MTOK; float* ss2 = ss1 + 4 * MTOK; float* ss3 = ss2 + 4 * MTOK; float* ss4 = ss3 + 4 * MTOK;
    bf16_t* HB = (bf16_t*)(ws + WS_HB); bf16_t* PB = (bf16_t*)(ws + WS_PB); bf16_t* ATT = (bf16_t*)(ws + WS_ATT); bf16_t* REC = (bf16_t*)(ws + WS_REC);
    bf16_t* ACT = (bf16_t*)(ws + WS_ACT); bf16_t* MG = (bf16_t*)(ws + WS_MG); bf16_t* TPB = (bf16_t*)a.out;     bf16_t* H4B = (bf16_t*)(ws + WS_ATT);
    bf16_t* Qb = (bf16_t*)(ws + WS_Q); bf16_t* Kb = (bf16_t*)(ws + WS_K); bf16_t* VT = (bf16_t*)(ws + WS_VT); bf16_t* RQ = (bf16_t*)(ws + WS_RQ); bf16_t* RG = (bf16_t*)(ws + WS_RG);
    bf16_t* RIT = (bf16_t*)(ws + WS_RIT); bf16_t* SG = (bf16_t*)(ws + WS_SG); bf16_t* GA = (bf16_t*)(ws + WS_GA); bf16_t* GB = (bf16_t*)(ws + WS_GB);
    float* out = a.out;
    using pg8::Gemm; using pg8::StaticOrder; using pg8::gemm_phase;
    volatile LAS unsigned* MISC = (volatile LAS unsigned*)(lds + MISC_OFF);
    if (threadIdx.x < 32) MISC[threadIdx.x] = 0u;
    __syncthreads();
    const XcdBarrier xbar = xcd_barrier_post((unsigned*)(ws + WS_BAR), MISC + 8);

    { FRESH_TID(); p0_prologue(a, lds, tid, lane, wave, G); }
    grid.sync();

    { Gemm g{HB, (const bf16_t*)(ws + WS_W1IN), MTOK, 2 * DFF, DM}; StaticOrder S; S.init(MTOK, 2 * DFF, G, bx); pg8::EpiSwiglu E{ACT, ss0};
      gemm_phase<pg8::EpiSwiglu, StaticOrder, true, true>(lds, g, S, E); }
    xcd_barrier(xbar);
    { Gemm g{ACT, (const bf16_t*)(ws + WS_W1OUT), MTOK, DM, DFF}; StaticOrder S; S.init(MTOK, DM, G, bx); pg8::EpiRes<true> E{a.in[0], HB, ss1, 0.5f};
      gemm_phase<pg8::EpiRes<true>, StaticOrder, true, true>(lds, g, S, E); }
    xcd_barrier(xbar);
    { Gemm g{HB, (const bf16_t*)(ws + WS_WIN), MTOK, INW, DM}; StaticOrder S; S.init(MTOK, INW, G, bx); pg8::EpiWin E{ss1, a.in[3], Qb, Kb, VT, RQ, RG, RIT, SG, GA, GB};
      gemm_phase<pg8::EpiWin, StaticOrder, true, true>(lds, g, S, E); }
    xcd_barrier(xbar);
    {
        const int nrec = (G >= 256) ? 128 : G / 2;
        if (bx < nrec) { FRESH_TID(); for (int u = bx; u < NBATCH * 4; u += nrec) REC_UNIT(lds, u, RQ, RG, RIT, SG, a.in[10], REC, tid); }
        if (bx >= nrec) {
            const int na = G - nrec;
            { FRESH_TID();
            attn_mfma_units(lds, bx - nrec, na, NBATCH * 16 * 2, Qb, Kb, VT, a.in[2], a.in[9], ATT, tid); }
            Gemm g{PB, (const bf16_t*)(ws + WS_WP), MTOK, DM, PLE}; StaticOrder S; S.init(MTOK, DM, na, bx - nrec); pg8::EpiStoreBf16 E{TPB};
            gemm_phase<pg8::EpiStoreBf16, StaticOrder, true, true>(lds, g, S, E);
        }
    }
    xcd_barrier(xbar);
    { Gemm g{ATT, (const bf16_t*)(ws + WS_WATT), MTOK, DM, 512}; StaticOrder S; S.init(MTOK, DM, G, bx); pg8::EpiGate<false> E{GA, MG};
      gemm_phase<pg8::EpiGate<false>, StaticOrder, true, true>(lds, g, S, E); }
    { Gemm g{REC, (const bf16_t*)(ws + WS_WREC), MTOK, DM, 512}; StaticOrder S; S.init(MTOK, DM, G, bx); pg8::EpiGate<true> E{GB, MG};
      gemm_phase<pg8::EpiGate<true>, StaticOrder, true, true>(lds, g, S, E); }
    xcd_barrier(xbar);
    { Gemm g{MG, (const bf16_t*)(ws + WS_WOUT), MTOK, DM, DM}; StaticOrder S; S.init(MTOK, DM, G, bx); pg8::EpiRes<false> E{nullptr, HB, ss2, 1.0f};
      gemm_phase<pg8::EpiRes<false>, StaticOrder, true, true>(lds, g, S, E); }
    xcd_barrier(xbar);
    { Gemm g{HB, (const bf16_t*)(ws + WS_W2IN), MTOK, 2 * DFF, DM}; StaticOrder S; S.init(MTOK, 2 * DFF, G, bx); pg8::EpiSwiglu E{ACT, ss2};
      gemm_phase<pg8::EpiSwiglu, StaticOrder, true, true>(lds, g, S, E); }
    xcd_barrier(xbar);
    { Gemm g{ACT, (const bf16_t*)(ws + WS_W2OUT), MTOK, DM, DFF}; StaticOrder S; S.init(MTOK, DM, G, bx); pg8::EpiRes<false> E{nullptr, HB, ss3, 0.5f};
      gemm_phase<pg8::EpiRes<false>, StaticOrder, true, true>(lds, g, S, E); }
    xcd_barrier(xbar);
    { Gemm g{HB, (const bf16_t*)(ws + WS_WG), MTOK, DM, DM}; StaticOrder S; S.init(MTOK, DM, G, bx); pg8::EpiPle2 E{ss3, TPB, HB, H4B, ss4};
      gemm_phase<pg8::EpiPle2, StaticOrder, true, true>(lds, g, S, E); }
    xcd_barrier(xbar);
    {
        FRESH_TID();
        const int gw = bx * 8 + wave, NGW = G * 8;
        const f32x4* gf = (const f32x4*)a.in[20] + lane;
        f32x4 gv[4];
#pragma unroll
        for (int j = 0; j < 4; ++j) gv[j] = gf[64 * j];
        for (int m = gw; m < MTOK; m += 4 * NGW) {
            u32x2 w[4][4]; float rin[4];
#pragma unroll
            for (int q = 0; q < 4; ++q) { const int mq = (m + q * NGW < MTOK) ? m + q * NGW : m; const u32x2* hr = (const u32x2*)(H4B + (size_t)mq * DM) + lane;
                { const f32x4 q4 = *(const f32x4*)(ss4 + (size_t)mq * 4); rin[q] = (q4[0] + q4[1]) + (q4[2] + q4[3]); }
#pragma unroll
                for (int j = 0; j < 4; ++j) w[q][j] = __builtin_nontemporal_load(hr + 64 * j); }
#pragma unroll
            for (int q = 0; q < 4; ++q) { const int mq = m + q * NGW;
                if (mq < MTOK) { const float rinv = __builtin_amdgcn_rsqf(rin[q] * (1.0f / 1024.0f) + 1e-6f); f32x4* xr = (f32x4*)(out + (size_t)mq * DM) + lane;
#pragma unroll
                    for (int j = 0; j < 4; ++j) { f32x4 v = (f32x4){bflo(w[q][j].x), bfhi(w[q][j].x), bflo(w[q][j].y), bfhi(w[q][j].y)}; v = v * rinv * gv[j]; __builtin_nontemporal_store(v, xr + 64 * j); } } }
        }
    }
}

extern "C" void kernel_launch(void* const* d_in, const int* in_sizes, int n_in, void* d_out, int out_size, void* d_ws, size_t ws_size, hipStream_t stream) {
    static int grid = 0;
    if (grid == 0) {
        int dev = 0, cus = 0, per_cu = 0;
        (void)hipGetDevice(&dev);
        (void)hipDeviceGetAttribute(&cus, hipDeviceAttributeMultiprocessorCount, dev);
        (void)hipFuncSetAttribute((const void*)fwd_megakernel, hipFuncAttributeMaxDynamicSharedMemorySize, LDS_BYTES);
        if (hipOccupancyMaxActiveBlocksPerMultiprocessor(&per_cu, (const void*)fwd_megakernel, 512, LDS_BYTES) != hipSuccess || per_cu < 1) per_cu = 1;
        (void)hipGetLastError();
        if (cus <= 0) cus = 256;
        grid = cus * per_cu;
    }
    (void)hipMemsetAsync((unsigned char*)d_ws + WS_BAR, 0, XCD_BAR_WORDS * 4, stream);
    Args a{};
    for (int i = 0; i < 21; ++i) a.in[i] = (const float*)d_in[i];
    a.out = (float*)d_out; a.ws = (unsigned char*)d_ws;
    void* args[] = {&a};
    hipError_t e = hipLaunchCooperativeKernel((const void*)fwd_megakernel, dim3(grid), dim3(512), args, LDS_BYTES, stream);
    if (e != hipSuccess) fprintf(stderr, "cooperative launch failed: %s (grid %d)\n", hipGetErrorString(e), grid);
}
```

```cpp
#include <hip/hip_runtime.h>
#include <hip/hip_cooperative_groups.h>
#include <cstdio>
#include <cstdint>
namespace cg = cooperative_groups;
namespace pg8 {
#define PG8_LAS __attribute__((address_space(3)))
typedef unsigned short bf16_t;
typedef short bf16x8 __attribute__((ext_vector_type(8)));
typedef float f32x4 __attribute__((ext_vector_type(4)));
typedef unsigned u32x4 __attribute__((ext_vector_type(4)));
constexpr int BM = 256, BK = 64, HALF = 128, HTB = HALF * BK * 2  , STAGE_BYTES = 8 * HTB, NXCD = 8, WGM = 8;

__host__ __device__ __forceinline__ int lds_byte(int r, int c) { const int st = (r >> 4) * 2 + (c >> 5), rr = r & 15, cc = c & 31, ob = rr * 64 + cc * 2; return st * 1024 + (ob ^ (((ob >> 9) & 1) << 5)); }
__host__ __device__ __forceinline__ void stage_rc(int b, int& R, int& C) { const int st = b / 1024, sb = b % 1024, swz = sb ^ (((sb >> 9) & 1) << 5); R = (st >> 1) * 16 + swz / 64; C = (st & 1) * 32 + (swz % 64) / 2; }
__host__ __device__ __forceinline__ int perm32(int rho) { const int n = rho >> 4, i = rho & 15; return 8 * (i >> 2) + 4 * n + (i & 3); }

struct Unit { int pm, pn; };
struct Gemm { const bf16_t* A; const bf16_t* Bt; int M, N, K; };

struct StaticOrder {
    int nM, nN, nwg, G, c;
    __host__ __device__ void init(int M, int N, int G_, int c_) { nM = M / BM; nN = N / BM; nwg = nM * nN; G = G_; c = c_; }
    __host__ __device__ bool next(int i, Unit& u) const {
        const long L = (long)i * G + c; if (L >= nwg) return false;
        int wgid = (int)L; { const int q = nwg / NXCD, r = nwg % NXCD, xcd = wgid % NXCD, off = wgid / NXCD; wgid = (xcd < r ? xcd * (q + 1) : r * (q + 1) + (xcd - r) * q) + off; }
        const int nig = WGM * nN, gid = wgid / nig, fm = gid * WGM, gsz = (nM - fm) < WGM ? (nM - fm) : WGM;
        u.pm = fm + ((wgid % nig) % gsz); u.pn = (wgid % nig) / gsz; return true;
    }
    __device__ __forceinline__ void a_ready(const Unit&) const {}
    __device__ __forceinline__ void done(const Unit&) const {}
};

__device__ __forceinline__ unsigned cvt_pk_bf16(float lo, float hi) { unsigned r; asm volatile("v_cvt_pk_bf16_f32 %0, %1, %2" : "=v"(r) : "v"(lo), "v"(hi)); return r; }
typedef float f32x2 __attribute__((ext_vector_type(2)));
__device__ __forceinline__ float sigm(float x) { return __builtin_amdgcn_rcpf(1.0f + __builtin_amdgcn_exp2f(-1.44269504f * x)); }
__device__ __forceinline__ float bflo(unsigned w) { return __uint_as_float(w << 16); }
__device__ __forceinline__ float bfhi(unsigned w) { return __uint_as_float(w & 0xffff0000u); }
constexpr float RMS_EPS = 1e-6f;

struct EpiSwiglu {
    static constexpr bool PERM = true, AFTER_DRAIN = false, MIDK = false, ROWSTAT = true;
    bf16_t* O; const float* ss;
    __device__ __forceinline__ void operator()(const f32x4 (&acc)[2][2][4][2], const Unit& u, int wr, int wc, int fr, int fq, const PG8_LAS float* rs, PG8_LAS float* xch, int tid) const {
        const int row0 = u.pm * BM + wr * 64 + fr, col0 = u.pn * 128 + wc * 32 + 8 * fq;
        float rv[2][4];
#pragma unroll
        for (int ai = 0; ai < 2; ++ai)
#pragma unroll
            for (int m = 0; m < 4; ++m) { const f32x4 q4 = *(const PG8_LAS f32x4*)(rs + (ai * HALF + wr * 64 + m * 16 + fr) * 4); rv[ai][m] = (q4[0] + q4[1]) + (q4[2] + q4[3]); }
#pragma unroll
        for (int ai = 0; ai < 2; ++ai)
#pragma unroll
            for (int m = 0; m < 4; ++m) {
                const int row = row0 + ai * HALF + m * 16;
                const float rinv = __builtin_amdgcn_rsqf(rv[ai][m] * (1.0f / 1024.0f) + RMS_EPS);
                const float nrl = -1.44269504f * rinv, rsq2 = rinv * rinv;
                unsigned ww[4];
#pragma unroll
                for (int n = 0; n < 2; ++n) {
                    const f32x4 ag = acc[ai][0][m][n], au = acc[ai][1][m][n];
                    const f32x4 t = ag * nrl;
                    f32x4 e; e[0] = __builtin_amdgcn_exp2f(t[0]); e[1] = __builtin_amdgcn_exp2f(t[1]); e[2] = __builtin_amdgcn_exp2f(t[2]); e[3] = __builtin_amdgcn_exp2f(t[3]);
                    const f32x4 d = e + 1.0f;
                    f32x4 r; r[0] = __builtin_amdgcn_rcpf(d[0]); r[1] = __builtin_amdgcn_rcpf(d[1]); r[2] = __builtin_amdgcn_rcpf(d[2]); r[3] = __builtin_amdgcn_rcpf(d[3]);
                    const f32x4 a = (ag * au) * (r * rsq2);
                    ww[2 * n] = cvt_pk_bf16(a[0], a[1]); ww[2 * n + 1] = cvt_pk_bf16(a[2], a[3]);
                }
                u32x4 w; w.x = ww[0]; w.y = ww[1]; w.z = ww[2]; w.w = ww[3];
                *(u32x4*)(O + (size_t)row * 2816 + col0) = w;
            }
    }
};

#define UNPK8(V_, lo4, hi4) do { const u32x4 v__ = (V_); lo4 = (f32x4){bflo(v__.x), bfhi(v__.x), bflo(v__.y), bfhi(v__.y)}; hi4 = (f32x4){bflo(v__.z), bfhi(v__.z), bflo(v__.w), bfhi(v__.w)}; } while (0)
#define SUMSQ8(a, b) (((a)[0] * (a)[0] + (a)[1] * (a)[1]) + ((a)[2] * (a)[2] + (a)[3] * (a)[3]) + ((b)[0] * (b)[0] + (b)[1] * (b)[1]) + ((b)[2] * (b)[2] + (b)[3] * (b)[3]))
template <bool BASE_F32> struct EpiRes {
    static constexpr bool PERM = true, AFTER_DRAIN = false, MIDK = false, ROWSTAT = false;
    const float* base; bf16_t* hb; float* ssout; float alpha;
    __device__ __forceinline__ void operator()(const f32x4 (&acc)[2][2][4][2], const Unit& u, int wr, int wc, int fr, int fq, const PG8_LAS float* rs, PG8_LAS float* xch, int tid) const {
        const int row0 = u.pm * BM + wr * 64 + fr, col0 = u.pn * BM + wc * 32 + 8 * fq;
        if constexpr (!BASE_F32) {
            u32x4 pw[2][4][2];
#pragma unroll
            for (int ai = 0; ai < 2; ++ai)
#pragma unroll
                for (int m = 0; m < 4; ++m)
#pragma unroll
                    for (int bj = 0; bj < 2; ++bj) pw[ai][m][bj] = *(const u32x4*)(hb + (size_t)(row0 + ai * HALF + m * 16) * 1024 + col0 + bj * HALF);
#pragma unroll
            for (int ai = 0; ai < 2; ++ai)
#pragma unroll
                for (int m = 0; m < 4; ++m) {
                    const int row = row0 + ai * HALF + m * 16; float s = 0.f;
#pragma unroll
                    for (int bj = 0; bj < 2; ++bj) {
                        const size_t off = (size_t)row * 1024 + col0 + bj * HALF;
                        f32x4 b0, b1; UNPK8(pw[ai][m][bj], b0, b1);
                        const f32x4 o0 = b0 + acc[ai][bj][m][0] * alpha, o1 = b1 + acc[ai][bj][m][1] * alpha;
                        u32x4 w; w.x = cvt_pk_bf16(o0[0], o0[1]); w.y = cvt_pk_bf16(o0[2], o0[3]); w.z = cvt_pk_bf16(o1[0], o1[1]); w.w = cvt_pk_bf16(o1[2], o1[3]);
                        *(u32x4*)(hb + off) = w;
                        s += SUMSQ8(o0, o1);
                    }
                    s += __shfl_xor(s, 16); s += __shfl_xor(s, 32);
                    if (fq == 0) xch[(row - u.pm * BM) * 4 + wc] = s;
                }
        } else {
            f32x4 pb[2][2][2][2];
#define ER_LOAD(slot, g) do { _Pragma("unroll") for (int mm = 0; mm < 2; ++mm) _Pragma("unroll") for (int bj = 0; bj < 2; ++bj) { \
                const size_t off_ = (size_t)(row0 + ((g) >> 1) * HALF + (2 * ((g) & 1) + mm) * 16) * 1024 + col0 + bj * HALF; \
                pb[slot][mm][bj][0] = __builtin_nontemporal_load((const f32x4*)(base + off_)); pb[slot][mm][bj][1] = __builtin_nontemporal_load((const f32x4*)(base + off_ + 4)); } } while (0)
            ER_LOAD(0, 0);
#pragma unroll
            for (int g = 0; g < 4; ++g) {
                if (g + 1 < 4) ER_LOAD((g + 1) & 1, g + 1);
#pragma unroll
                for (int mm = 0; mm < 2; ++mm) {
                    const int ai = g >> 1, m = 2 * (g & 1) + mm; const int row = row0 + ai * HALF + m * 16; float s = 0.f;
#pragma unroll
                    for (int bj = 0; bj < 2; ++bj) {
                        const size_t off = (size_t)row * 1024 + col0 + bj * HALF;
                        const f32x4 o0 = pb[g & 1][mm][bj][0] + acc[ai][bj][m][0] * alpha, o1 = pb[g & 1][mm][bj][1] + acc[ai][bj][m][1] * alpha;
                        u32x4 w; w.x = cvt_pk_bf16(o0[0], o0[1]); w.y = cvt_pk_bf16(o0[2], o0[3]); w.z = cvt_pk_bf16(o1[0], o1[1]); w.w = cvt_pk_bf16(o1[2], o1[3]);
                        *(u32x4*)(hb + off) = w;
                        s += SUMSQ8(o0, o1);
                    }
                    s += __shfl_xor(s, 16); s += __shfl_xor(s, 32);
                    if (fq == 0) xch[(row - u.pm * BM) * 4 + wc] = s;
                }
            }
#undef ER_LOAD
        }
        asm volatile("s_waitcnt lgkmcnt(0)\n\ts_barrier" ::: "memory");
        if (tid < BM) { const f32x4 q4 = *(const PG8_LAS f32x4*)(xch + tid * 4); ssout[((size_t)u.pm * BM + tid) * 4 + u.pn] = (q4[0] + q4[1]) + (q4[2] + q4[3]); }
    }
};

struct EpiWin {
    static constexpr bool PERM = true, AFTER_DRAIN = false, MIDK = false, ROWSTAT = true;
    const float* ss; const float* lbp; bf16_t *Q, *Kb, *VT, *RQ, *RG, *RIT, *SG, *GA, *GB;
    __device__ __forceinline__ void operator()(const f32x4 (&acc)[2][2][4][2], const Unit& u, int wr, int wc, int fr, int fq, const PG8_LAS float* rs, PG8_LAS float* xch, int tid) const {
        const int pn = u.pn, row0 = u.pm * BM + wr * 64 + fr, cl = wc * 32 + 8 * fq;
        int kind = 0; float scale = 1.f; bf16_t* dst = Q; int pitch = 512, cbase = 0; int trw = 0;
        if (pn < 2) { dst = Q; cbase = pn * 256; scale = 0.125f; }
        else if (pn == 2) { dst = Kb; pitch = 128; cbase = 0; }
        else if (pn < 5) { dst = RQ; cbase = (pn - 3) * 256; }
        else if (pn < 7) { dst = RG; cbase = (pn - 5) * 256; kind = 1; }
        else if (pn < 9) { dst = RIT; cbase = (pn - 7) * 256; trw = 512; }
        else if (pn < 11) { dst = SG; cbase = (pn - 9) * 256; kind = 2; }
        else { dst = GA; pitch = 1024; cbase = (pn - 11) * 128; kind = 3; }
        f32x4 lb[2][2];
#pragma unroll
        for (int bj = 0; bj < 2; ++bj)
#pragma unroll
            for (int n = 0; n < 2; ++n) lb[bj][n] = (f32x4){0.f, 0.f, 0.f, 0.f};
        if (kind == 1) {
#pragma unroll
            for (int bj = 0; bj < 2; ++bj)
#pragma unroll
                for (int n = 0; n < 2; ++n) {
                    const int c = cbase + bj * HALF + cl + 4 * n;
                    const f32x4 p0 = *(const f32x4*)(lbp + c), p1 = *(const f32x4*)(lbp + 512 + c);
#pragma unroll
                    for (int j = 0; j < 4; ++j) lb[bj][n][j] = sigm(p0[j] - p1[j]);
                }
        }
        float rv[2][4];
#pragma unroll
        for (int ai = 0; ai < 2; ++ai)
#pragma unroll
            for (int m = 0; m < 4; ++m) { const f32x4 q4 = *(const PG8_LAS f32x4*)(rs + (ai * HALF + wr * 64 + m * 16 + fr) * 4); rv[ai][m] = (q4[0] + q4[1]) + (q4[2] + q4[3]); }
        if (kind == 3) {
#pragma unroll
            for (int ai = 0; ai < 2; ++ai)
#pragma unroll
                for (int m = 0; m < 4; ++m) {
                    const int row = row0 + ai * HALF + m * 16;
                    const float nrl = -1.44269504f * __builtin_amdgcn_rsqf(rv[ai][m] * (1.0f / 1024.0f) + RMS_EPS);
                    f32x4 rt[2], sb[2];
#pragma unroll
                    for (int n = 0; n < 2; ++n) {
                        const f32x4 ta = acc[ai][0][m][n] * nrl, tb = acc[ai][1][m][n] * nrl;
#pragma unroll
                        for (int j = 0; j < 4; ++j) { const float da = 1.0f + __builtin_amdgcn_exp2f(ta[j]), db = 1.0f + __builtin_amdgcn_exp2f(tb[j]); const float rb = __builtin_amdgcn_rcpf(db);
                            sb[n][j] = rb; rt[n][j] = fminf(db * __builtin_amdgcn_rcpf(da), 3.0e38f); }
                    }
                    u32x4 w; w.x = cvt_pk_bf16(rt[0][0], rt[0][1]); w.y = cvt_pk_bf16(rt[0][2], rt[0][3]); w.z = cvt_pk_bf16(rt[1][0], rt[1][1]); w.w = cvt_pk_bf16(rt[1][2], rt[1][3]);
                    *(u32x4*)(GA + (size_t)row * 1024 + cbase + cl) = w;
                    w.x = cvt_pk_bf16(sb[0][0], sb[0][1]); w.y = cvt_pk_bf16(sb[0][2], sb[0][3]); w.z = cvt_pk_bf16(sb[1][0], sb[1][1]); w.w = cvt_pk_bf16(sb[1][2], sb[1][3]);
                    *(u32x4*)(GB + (size_t)row * 1024 + cbase + cl) = w;
                }
            return;
        }
#pragma unroll
        for (int ai = 0; ai < 2; ++ai)
#pragma unroll
            for (int m = 0; m < 4; ++m) {
                const int row = row0 + ai * HALF + m * 16;
                const float rinv = __builtin_amdgcn_rsqf(rv[ai][m] * (1.0f / 1024.0f) + RMS_EPS);
#pragma unroll
                for (int bj = 0; bj < 2; ++bj) {
                    f32x4 v[2];
#pragma unroll
                    for (int n = 0; n < 2; ++n) {
                        v[n] = acc[ai][bj][m][n] * rinv;
                        if (kind == 0) v[n] = v[n] * scale;
                        else {
#pragma unroll
                            for (int j = 0; j < 4; ++j) v[n][j] = sigm(v[n][j]);
                            if (kind == 1) {
#pragma unroll
                                for (int j = 0; j < 4; ++j) v[n][j] = __builtin_amdgcn_logf(lb[bj][n][j] + (1.0f - lb[bj][n][j]) * v[n][j]) * 0.69314718056f;
                            }
                        }
                    }
                    const bool tr = (trw != 0) || (pn == 2 && bj == 1);
                    if (!tr) {
                        u32x4 w; w.x = cvt_pk_bf16(v[0][0], v[0][1]); w.y = cvt_pk_bf16(v[0][2], v[0][3]); w.z = cvt_pk_bf16(v[1][0], v[1][1]); w.w = cvt_pk_bf16(v[1][2], v[1][3]);
                        *(u32x4*)(dst + (size_t)row * pitch + cbase + bj * HALF + cl) = w;
                    } else {
                        bf16_t* tb = (pn == 2) ? VT : RIT; const int cw = (pn == 2) ? 128 : 512; const int c0 = (pn == 2) ? cl : cbase + bj * HALF + cl;
                        bf16_t* p = tb + (((size_t)((row >> 11) * cw + c0)) << 11) + (row & 2047);
#pragma unroll
                        for (int n = 0; n < 2; ++n)
#pragma unroll
                            for (int j = 0; j < 4; ++j) p[(size_t)(4 * n + j) << 11] = (bf16_t)(cvt_pk_bf16(v[n][j], v[n][j]) & 0xffffu);
                    }
                }
            }
    }
};

template <bool ADD> struct EpiGate {
    static constexpr bool PERM = true, AFTER_DRAIN = false, MIDK = false, ROWSTAT = false;
    const bf16_t* gate; bf16_t* MG;
    __device__ __forceinline__ void operator()(const f32x4 (&acc)[2][2][4][2], const Unit& u, int wr, int wc, int fr, int fq, const PG8_LAS float* rs, PG8_LAS float* xch, int tid) const {
        const int row0 = u.pm * BM + wr * 64 + fr, col0 = u.pn * BM + wc * 32 + 8 * fq;
        u32x4 gwb[2][2][2], pwb[2][2][2];
#define EG_LOAD(slot, g) do { _Pragma("unroll") for (int mm = 0; mm < 2; ++mm) _Pragma("unroll") for (int bj = 0; bj < 2; ++bj) { \
            const size_t off_ = (size_t)(row0 + ((g) >> 1) * HALF + (2 * ((g) & 1) + mm) * 16) * 1024 + col0 + bj * HALF; \
            gwb[slot][mm][bj] = *(const u32x4*)(gate + off_); if (ADD) pwb[slot][mm][bj] = *(const u32x4*)(MG + off_); } } while (0)
        EG_LOAD(0, 0);
#pragma unroll
        for (int g = 0; g < 4; ++g) {
            if (g + 1 < 4) EG_LOAD((g + 1) & 1, g + 1);
#pragma unroll
            for (int mm = 0; mm < 2; ++mm) {
                const int ai = g >> 1, m = 2 * (g & 1) + mm; const int row = row0 + ai * HALF + m * 16;
#pragma unroll
                for (int bj = 0; bj < 2; ++bj) {
                    const size_t off = (size_t)row * 1024 + col0 + bj * HALF;
                    f32x4 g0, g1; UNPK8(gwb[g & 1][mm][bj], g0, g1);
                    f32x4 o0 = g0 * acc[ai][bj][m][0], o1 = g1 * acc[ai][bj][m][1];
                    if (ADD) { f32x4 p0, p1; UNPK8(pwb[g & 1][mm][bj], p0, p1); o0 += p0; o1 += p1; }
                    u32x4 w; w.x = cvt_pk_bf16(o0[0], o0[1]); w.y = cvt_pk_bf16(o0[2], o0[3]); w.z = cvt_pk_bf16(o1[0], o1[1]); w.w = cvt_pk_bf16(o1[2], o1[3]);
                    *(u32x4*)(MG + off) = w;
                }
            }
        }
#undef EG_LOAD
    }
};

struct EpiStoreBf16 {
    static constexpr bool PERM = true, AFTER_DRAIN = false, MIDK = false, ROWSTAT = false;
    bf16_t* T;
    __device__ __forceinline__ void operator()(const f32x4 (&acc)[2][2][4][2], const Unit& u, int wr, int wc, int fr, int fq, const PG8_LAS float* rs, PG8_LAS float* xch, int tid) const {
        const int row0 = u.pm * BM + wr * 64 + fr, col0 = u.pn * BM + wc * 32 + 8 * fq;
#pragma unroll
        for (int ai = 0; ai < 2; ++ai)
#pragma unroll
            for (int m = 0; m < 4; ++m) {
                const int row = row0 + ai * HALF + m * 16;
#pragma unroll
                for (int bj = 0; bj < 2; ++bj) {
                    const size_t off = (size_t)row * 1024 + col0 + bj * HALF;
                    const f32x4 a0 = acc[ai][bj][m][0], a1 = acc[ai][bj][m][1];
                    u32x4 w; w.x = cvt_pk_bf16(a0[0], a0[1]); w.y = cvt_pk_bf16(a0[2], a0[3]); w.z = cvt_pk_bf16(a1[0], a1[1]); w.w = cvt_pk_bf16(a1[2], a1[3]);
                    *(u32x4*)(T + off) = w;
                }
            }
    }
};

struct EpiPle2 {
    static constexpr bool PERM = true, AFTER_DRAIN = false, MIDK = false, ROWSTAT = true;
    const float* ss; const bf16_t* T; const bf16_t* h3b; bf16_t* h4b; float* ssout;
    __device__ __forceinline__ void operator()(const f32x4 (&acc)[2][2][4][2], const Unit& u, int wr, int wc, int fr, int fq, const PG8_LAS float* rs, PG8_LAS float* xch, int tid) const {
        const int row0 = u.pm * BM + wr * 64 + fr, col0 = u.pn * BM + wc * 32 + 8 * fq;
        float rv[2][4];
#pragma unroll
        for (int ai = 0; ai < 2; ++ai)
#pragma unroll
            for (int m = 0; m < 4; ++m) { const f32x4 q4 = *(const PG8_LAS f32x4*)(rs + (ai * HALF + wr * 64 + m * 16 + fr) * 4); rv[ai][m] = (q4[0] + q4[1]) + (q4[2] + q4[3]); }
        u32x4 hwb[2][2], twb[2][2];
#define EP_LOAD(slot, g) do { _Pragma("unroll") for (int bj = 0; bj < 2; ++bj) { \
            const size_t off_ = (size_t)(row0 + ((g) >> 2) * HALF + ((g) & 3) * 16) * 1024 + col0 + bj * HALF; \
            hwb[slot][bj] = *(const u32x4*)(h3b + off_); twb[slot][bj] = *(const u32x4*)(T + off_); } } while (0)
        EP_LOAD(0, 0);
#pragma unroll
        for (int g = 0; g < 8; ++g) {
            if (g + 1 < 8) EP_LOAD((g + 1) & 1, g + 1);
            {
                const int ai = g >> 2, m = g & 3; const int row = row0 + ai * HALF + m * 16; float s = 0.f;
                const float rinv = __builtin_amdgcn_rsqf(rv[ai][m] * (1.0f / 1024.0f) + RMS_EPS);
#pragma unroll
                for (int bj = 0; bj < 2; ++bj) {
                    const size_t off = (size_t)row * 1024 + col0 + bj * HALF;
                    f32x4 b0, b1, t0, t1; UNPK8(hwb[g & 1][bj], b0, b1); UNPK8(twb[g & 1][bj], t0, t1);
                    f32x4 o0, o1;
#pragma unroll
                    for (int j = 0; j < 4; ++j) { o0[j] = b0[j] + sigm(acc[ai][bj][m][0][j] * rinv) * t0[j]; o1[j] = b1[j] + sigm(acc[ai][bj][m][1][j] * rinv) * t1[j]; }
                    u32x4 w; w.x = cvt_pk_bf16(o0[0], o0[1]); w.y = cvt_pk_bf16(o0[2], o0[3]); w.z = cvt_pk_bf16(o1[0], o1[1]); w.w = cvt_pk_bf16(o1[2], o1[3]);
                    *(u32x4*)(h4b + off) = w;
                    s += SUMSQ8(o0, o1);
                }
                s += __shfl_xor(s, 16); s += __shfl_xor(s, 32);
                if (fq == 0) xch[(row - u.pm * BM) * 4 + wc] = s;
            }
        }
#undef EP_LOAD
        asm volatile("s_waitcnt lgkmcnt(0)\n\ts_barrier" ::: "memory");
        if (tid < BM) { const f32x4 q4 = *(const PG8_LAS f32x4*)(xch + tid * 4); ssout[((size_t)u.pm * BM + tid) * 4 + u.pn] = (q4[0] + q4[1]) + (q4[2] + q4[3]); }
    }
};


struct EpiMerge {
    static constexpr bool PERM = true, AFTER_DRAIN = false, MIDK = true, ROWSTAT = false;
    const bf16_t* RT; const bf16_t* SB; bf16_t* MG;
    __device__ __forceinline__ void mid(f32x4 (&acc)[2][2][4][2], const Unit& u, int wr, int wc, int fr, int fq) const {
        const int row0 = u.pm * BM + wr * 64 + fr, col0 = u.pn * BM + wc * 32 + 8 * fq;
#pragma unroll
        for (int ai = 0; ai < 2; ++ai) {
            u32x4 gw[4][2];
#pragma unroll
            for (int m = 0; m < 4; ++m)
#pragma unroll
                for (int bj = 0; bj < 2; ++bj) gw[m][bj] = *(const u32x4*)(RT + (size_t)(row0 + ai * HALF + m * 16) * 1024 + col0 + bj * HALF);
#pragma unroll
            for (int m = 0; m < 4; ++m)
#pragma unroll
                for (int bj = 0; bj < 2; ++bj) { f32x4 g0, g1; UNPK8(gw[m][bj], g0, g1); acc[ai][bj][m][0] = acc[ai][bj][m][0] * g0; acc[ai][bj][m][1] = acc[ai][bj][m][1] * g1; }
        }
    }
    __device__ __forceinline__ void operator()(const f32x4 (&acc)[2][2][4][2], const Unit& u, int wr, int wc, int fr, int fq, const PG8_LAS float* rs, PG8_LAS float* xch, int tid) const {
        const int row0 = u.pm * BM + wr * 64 + fr, col0 = u.pn * BM + wc * 32 + 8 * fq;
        u32x4 gw[2][4][2];
#pragma unroll
        for (int ai = 0; ai < 2; ++ai)
#pragma unroll
            for (int m = 0; m < 4; ++m)
#pragma unroll
                for (int bj = 0; bj < 2; ++bj) gw[ai][m][bj] = *(const u32x4*)(SB + (size_t)(row0 + ai * HALF + m * 16) * 1024 + col0 + bj * HALF);
#pragma unroll
        for (int ai = 0; ai < 2; ++ai)
#pragma unroll
            for (int m = 0; m < 4; ++m)
#pragma unroll
                for (int bj = 0; bj < 2; ++bj) {
                    f32x4 g0, g1; UNPK8(gw[ai][m][bj], g0, g1);
                    const f32x4 o0 = g0 * acc[ai][bj][m][0], o1 = g1 * acc[ai][bj][m][1];
                    u32x4 w; w.x = cvt_pk_bf16(o0[0], o0[1]); w.y = cvt_pk_bf16(o0[2], o0[3]); w.z = cvt_pk_bf16(o1[0], o1[1]); w.w = cvt_pk_bf16(o1[2], o1[3]);
                    *(u32x4*)(MG + (size_t)(row0 + ai * HALF + m * 16) * 1024 + col0 + bj * HALF) = w;
                }
    }
};

template <class Epi, class Sched, bool ALIGN_EPI = false, bool SP2 = false>
__device__ __forceinline__ void gemm_phase(PG8_LAS unsigned char* lds, const Gemm g, const Sched& S, const Epi& E) {
    int tid_ = threadIdx.x; asm volatile("" : "+v"(tid_));
    const int tid = tid_, wid = __builtin_amdgcn_readfirstlane(tid >> 6), lane = tid & 63, wr = wid >> 2, wc = wid & 3, fr = lane & 15, fq = lane >> 4;
    const int K = g.K, nt = K / BK;
    unsigned voffA[2], voffB[2];
#pragma unroll
    for (int i = 0; i < 2; ++i) { int R, C; stage_rc(tid * 16 + i * 8192, R, C); const int Rb = Epi::PERM ? ((R & ~31) + perm32(R & 31)) : R;
        voffA[i] = (unsigned)(R * K + C) * 2u; voffB[i] = (unsigned)(Rb * K + C) * 2u; }
    const size_t kstep = (size_t)(BK * 2);
    const size_t hstep = (size_t)HALF * K * 2;
    const size_t tstep = 2 * hstep;
    const unsigned ldsw = (unsigned)wid * 1024u;
    const int aoff = lds_byte(wr * 64 + fr, fq * 8), boff = lds_byte(wc * 32 + fr, fq * 8);
#define PG8_SA(b, h) (((b) * 2 + (h)) * HTB)
#define PG8_SB(b, h) ((4 + (b) * 2 + (h)) * HTB)
#define PG8_STAGE(bufoff, gbase, voff) do { _Pragma("unroll") for (int _i = 0; _i < 2; ++_i) \
        __builtin_amdgcn_global_load_lds((const unsigned*)((const char*)(gbase) + (voff)[_i]), (PG8_LAS unsigned*)(lds + (bufoff) + ldsw + _i * 8192), 16, 0, 0); } while (0)
#define PG8_LDA(dst, b, h) do { _Pragma("unroll") for (int m = 0; m < 4; ++m) _Pragma("unroll") for (int k = 0; k < 2; ++k) dst[m][k] = *(const PG8_LAS bf16x8*)(lds + PG8_SA(b, h) + aoff + m * 2048 + k * 1024); } while (0)
#define PG8_LDB(dst, b, h) do { _Pragma("unroll") for (int n = 0; n < 2; ++n) _Pragma("unroll") for (int k = 0; k < 2; ++k) dst[n][k] = *(const PG8_LAS bf16x8*)(lds + PG8_SB(b, h) + boff + n * 2048 + k * 1024); } while (0)
#define PG8_MMA(ai, bj, At, Bt) do { __builtin_amdgcn_s_setprio(1); _Pragma("unroll") for (int m = 0; m < 4; ++m) _Pragma("unroll") for (int n = 0; n < 2; ++n) _Pragma("unroll") for (int k = 0; k < 2; ++k) \
        acc[ai][bj][m][n] = __builtin_amdgcn_mfma_f32_16x16x32_bf16(Bt[n][k], At[m][k], acc[ai][bj][m][n], 0, 0, 0); __builtin_amdgcn_s_setprio(0); } while (0)
#define PG8_WAIT_V(n) asm volatile("s_waitcnt vmcnt(" #n ")" ::: "memory")
#define PG8_WAIT_L(n) asm volatile("s_waitcnt lgkmcnt(" #n ")" ::: "memory")
#define PG8_BAR __builtin_amdgcn_s_barrier()
#define PG8_SCHED __builtin_amdgcn_sched_barrier(0)
    Unit cur, nxt; int ui = 0;
    if (!S.next(0, cur)) return;
#define PG8_ROWSTAT_DMA(unit_, ui_) do { if constexpr (Epi::ROWSTAT) { if (wid < 4) { unsigned keep_; const float* gp_ = E.ss + ((size_t)(unit_).pm * BM + wid * 64 + lane) * 4; \
        const unsigned dst_ = (unsigned)__builtin_amdgcn_readfirstlane((int)((unsigned)(size_t)lds + 133120u + (unsigned)((ui_) & 1) * 4096u + (unsigned)wid * 1024u)); \
        asm volatile("s_mov_b32 %0, m0\n\ts_mov_b32 m0, %2\n\ts_nop 0\n\tglobal_load_lds_dwordx4 %1, off\n\ts_mov_b32 m0, %0" : "=&s"(keep_) : "v"(gp_), "s"(dst_) : "memory"); } } } while (0)
    PG8_ROWSTAT_DMA(cur, 0);
    f32x4 acc[2][2][4][2];
#pragma unroll
    for (int a = 0; a < 2; ++a)
#pragma unroll
        for (int b = 0; b < 2; ++b)
#pragma unroll
            for (int m = 0; m < 4; ++m)
#pragma unroll
                for (int n = 0; n < 2; ++n) acc[a][b][m][n] = (f32x4){0.f, 0.f, 0.f, 0.f};
    bf16x8 At[4][2], B0[2][2], B1[2][2];
    const char* cA = (const char*)g.A + (size_t)cur.pm * tstep; const char* cB = (const char*)g.Bt + (size_t)cur.pn * tstep;
    S.a_ready(cur);
    if constexpr (SP2) {
        PG8_STAGE(PG8_SB(0, 0), cB, voffB); PG8_STAGE(PG8_SB(0, 1), cB + hstep, voffB); PG8_STAGE(PG8_SA(0, 0), cA, voffA); PG8_STAGE(PG8_SA(0, 1), cA + hstep, voffA);
        if (wr == 1) PG8_BAR;
        PG8_WAIT_V(2); PG8_BAR;
        PG8_STAGE(PG8_SB(1, 0), cB + kstep, voffB); PG8_STAGE(PG8_SA(1, 0), cA + kstep, voffA); PG8_STAGE(PG8_SB(1, 1), cB + hstep + kstep, voffB);
        PG8_WAIT_V(6); PG8_BAR;
    } else {
        PG8_STAGE(PG8_SB(0, 0), cB, voffB); PG8_STAGE(PG8_SA(0, 0), cA, voffA); PG8_STAGE(PG8_SB(0, 1), cB + hstep, voffB); PG8_STAGE(PG8_SA(0, 1), cA + hstep, voffA);
        if (wr == 1) PG8_BAR;
        PG8_WAIT_V(4); PG8_BAR;
        PG8_STAGE(PG8_SB(1, 0), cB + kstep, voffB); PG8_STAGE(PG8_SA(1, 0), cA + kstep, voffA); PG8_STAGE(PG8_SB(1, 1), cB + hstep + kstep, voffB);
        PG8_WAIT_V(6); PG8_BAR;
    }
    for (;;) {
        const bool has_next = S.next(ui + 1, nxt);
        const char* nA = has_next ? (const char*)g.A + (size_t)nxt.pm * tstep : cA; const char* nB = has_next ? (const char*)g.Bt + (size_t)nxt.pn * tstep : cB;
        for (int t = 0; t < nt; t += 2) {
            const bool last = (t == nt - 2);
            if constexpr (Epi::MIDK) { if (t == nt / 2) { int t3_ = threadIdx.x; asm volatile("" : "+v"(t3_)); const int l3_ = t3_ & 63, w3_ = __builtin_amdgcn_readfirstlane(t3_ >> 6);
                E.mid(acc, cur, w3_ >> 2, w3_ & 3, l3_ & 15, l3_ >> 4); } }
            const char* a1 = cA + (size_t)(t + 1) * kstep;
            const char* a2 = last ? nA : cA + (size_t)(t + 2) * kstep; const char* b2 = last ? nB : cB + (size_t)(t + 2) * kstep;
            const char* a3 = a2 + kstep; const char* b3 = b2 + kstep;
            if (last && has_next) S.a_ready(nxt);
            if constexpr (SP2) {
            PG8_LDB(B0, 0, 0); PG8_LDB(B1, 0, 1); PG8_SCHED; PG8_LDA(At, 0, 0); PG8_STAGE(PG8_SA(1, 1), a1 + hstep, voffA);
            PG8_WAIT_V(8); PG8_WAIT_L(0); PG8_BAR; PG8_MMA(0, 0, At, B0); PG8_MMA(0, 1, At, B1); PG8_BAR; PG8_SCHED;
            PG8_LDA(At, 0, 1); PG8_STAGE(PG8_SB(0, 0), b2, voffB); PG8_STAGE(PG8_SB(0, 1), b2 + hstep, voffB); PG8_STAGE(PG8_SA(0, 0), a2, voffA);
            PG8_WAIT_V(8); PG8_WAIT_L(0); PG8_BAR; PG8_MMA(1, 0, At, B0); PG8_MMA(1, 1, At, B1); PG8_BAR; PG8_SCHED;
            PG8_LDB(B0, 1, 0); PG8_LDB(B1, 1, 1); PG8_SCHED; PG8_LDA(At, 1, 0); PG8_STAGE(PG8_SA(0, 1), a2 + hstep, voffA);
            PG8_WAIT_V(8); PG8_WAIT_L(0); PG8_BAR; PG8_MMA(0, 0, At, B0); PG8_MMA(0, 1, At, B1); PG8_BAR; PG8_SCHED;
            PG8_LDA(At, 1, 1); PG8_STAGE(PG8_SB(1, 0), b3, voffB); PG8_STAGE(PG8_SB(1, 1), b3 + hstep, voffB); PG8_STAGE(PG8_SA(1, 0), a3, voffA);
            PG8_WAIT_V(8); PG8_WAIT_L(0); PG8_BAR; PG8_MMA(1, 0, At, B0); PG8_MMA(1, 1, At, B1); PG8_BAR; PG8_SCHED;
            } else {
            PG8_LDB(B0, 0, 0); PG8_SCHED; PG8_LDA(At, 0, 0); PG8_STAGE(PG8_SA(1, 1), a1 + hstep, voffA);
            PG8_WAIT_L(8); PG8_BAR; PG8_WAIT_L(0); PG8_MMA(0, 0, At, B0); PG8_BAR; PG8_SCHED;
            PG8_LDB(B1, 0, 1); PG8_STAGE(PG8_SB(0, 0), b2, voffB);
            PG8_BAR; PG8_WAIT_L(0); PG8_MMA(0, 1, At, B1); PG8_BAR;
            PG8_LDA(At, 0, 1); PG8_STAGE(PG8_SA(0, 0), a2, voffA);
            PG8_BAR; PG8_WAIT_L(0); PG8_MMA(1, 0, At, B0); PG8_BAR; PG8_SCHED;
            PG8_STAGE(PG8_SB(0, 1), b2 + hstep, voffB);
            PG8_WAIT_V(6); PG8_BAR; PG8_MMA(1, 1, At, B1); PG8_BAR;
            PG8_LDB(B0, 1, 0); PG8_SCHED; PG8_LDA(At, 1, 0); PG8_STAGE(PG8_SA(0, 1), a2 + hstep, voffA);
            PG8_WAIT_L(8); PG8_BAR; PG8_WAIT_L(0); PG8_MMA(0, 0, At, B0); PG8_BAR; PG8_SCHED;
            PG8_LDB(B1, 1, 1); PG8_STAGE(PG8_SB(1, 0), b3, voffB);
            PG8_BAR; PG8_WAIT_L(0); PG8_MMA(0, 1, At, B1); PG8_BAR;
            PG8_LDA(At, 1, 1); PG8_STAGE(PG8_SA(1, 0), a3, voffA);
            PG8_BAR; PG8_WAIT_L(0); PG8_MMA(1, 0, At, B0); PG8_BAR; PG8_SCHED;
            PG8_STAGE(PG8_SB(1, 1), b3 + hstep, voffB);
            PG8_WAIT_V(6); PG8_BAR; PG8_MMA(1, 1, At, B1); PG8_BAR;
            }
        }
        if constexpr (ALIGN_EPI) { if (wr == 0) PG8_BAR; }
        if constexpr (!Epi::AFTER_DRAIN) { int t2_ = threadIdx.x; asm volatile("" : "+v"(t2_)); const int l2_ = t2_ & 63, w2_ = __builtin_amdgcn_readfirstlane(t2_ >> 6);
            E(acc, cur, w2_ >> 2, w2_ & 3, l2_ & 15, l2_ >> 4, (const PG8_LAS float*)(lds + 133120 + (ui & 1) * 4096), (PG8_LAS float*)(lds + 141312), t2_); S.done(cur); }
        if (!has_next) break;
#pragma unroll
        for (int a = 0; a < 2; ++a)
#pragma unroll
            for (int b = 0; b < 2; ++b)
#pragma unroll
                for (int m = 0; m < 4; ++m)
#pragma unroll
                    for (int n = 0; n < 2; ++n) acc[a][b][m][n] = (f32x4){0.f, 0.f, 0.f, 0.f};
        cur = nxt; cA = nA; cB = nB; ++ui;
        if constexpr (ALIGN_EPI) { if (wr == 1) PG8_BAR; }
        PG8_ROWSTAT_DMA(cur, ui);
    }
    PG8_WAIT_V(0);
    if constexpr (!ALIGN_EPI) { if (wr == 0) PG8_BAR; }
    PG8_BAR;
    if constexpr (Epi::AFTER_DRAIN) { E.fused(acc, cur, wr, wc, fr, fq, lds, wid, lane); S.done(cur); }
#undef PG8_SA
#undef PG8_SB
#undef PG8_STAGE
#undef PG8_LDA
#undef PG8_LDB
#undef PG8_MMA
#undef PG8_WAIT_V
#undef PG8_WAIT_L
#undef PG8_BAR
#undef PG8_SCHED
#undef PG8_ROWSTAT_DMA
}
}

constexpr int MTOK = 65536, DM = 1024, DFF = 2816, SEQL = 2048, NBATCH = 32, INW = 4864, PLE = 256;
constexpr int STAGGER_US = 2;
constexpr int LDS_BYTES = 147456;
#define LAS __attribute__((address_space(3)))
typedef unsigned short bf16_t;
typedef float f32x4 __attribute__((ext_vector_type(4)));
typedef unsigned u32x4 __attribute__((ext_vector_type(4)));
typedef unsigned u32x2 __attribute__((ext_vector_type(2)));

constexpr size_t MiB = 1u << 20;
constexpr size_t WS_SS = 948 * MiB;
constexpr size_t WS_BAR = 1536 * 1024;
constexpr int MISC_OFF = 132096;
constexpr size_t WS_W1IN = 2 * MiB;
constexpr size_t WS_W1OUT = WS_W1IN + (size_t)5632 * 1024 * 2;
constexpr size_t WS_WIN = WS_W1OUT + (size_t)1024 * 2816 * 2;
constexpr size_t WS_WATT = WS_WIN + (size_t)4864 * 1024 * 2;
constexpr size_t WS_WREC = WS_WATT + (size_t)1024 * 512 * 2;
constexpr size_t WS_WOUT = WS_WREC + (size_t)1024 * 512 * 2;
constexpr size_t WS_W2IN = WS_WOUT + (size_t)1024 * 1024 * 2;
constexpr size_t WS_W2OUT = WS_W2IN + (size_t)5632 * 1024 * 2;
constexpr size_t WS_WG = WS_W2OUT + (size_t)1024 * 2816 * 2;
constexpr size_t WS_WP = WS_WG + (size_t)1024 * 1024 * 2;
constexpr size_t WS_WEND = WS_WP + (size_t)1024 * 256 * 2;
static_assert(WS_WEND <= 52 * MiB, "weights");
constexpr size_t WS_HB = 52 * MiB;
constexpr size_t WS_PB = WS_HB + 128 * MiB;
constexpr size_t WS_ATT = WS_PB + 32 * MiB;
constexpr size_t WS_REC = WS_ATT + 64 * MiB;
constexpr size_t WS_A = WS_REC + 64 * MiB;
constexpr size_t WS_Q = WS_A;
constexpr size_t WS_K = WS_Q + 64 * MiB;
constexpr size_t WS_VT = WS_K + 16 * MiB;
constexpr size_t WS_RQ = WS_VT + 16 * MiB;
constexpr size_t WS_RG = WS_RQ + 64 * MiB;
constexpr size_t WS_RIT = WS_RG + 64 * MiB;
constexpr size_t WS_SG = WS_RIT + 64 * MiB;
constexpr size_t WS_GA = WS_SG + 64 * MiB;
constexpr size_t WS_GB = WS_GA + 128 * MiB;
constexpr size_t WS_END = WS_GB + 128 * MiB;
constexpr size_t WS_ACT = WS_A;
constexpr size_t WS_MG = WS_A;
constexpr size_t WS_T = WS_A;
static_assert(WS_END <= 948 * MiB && WS_SS + (size_t)5 * MTOK * 16 <= 1024 * MiB, "d_ws map");

__device__ __forceinline__ float bf2f(unsigned short b) { return __uint_as_float((unsigned)b << 16); }
__device__ __forceinline__ float bflo(unsigned w) { return __uint_as_float(w << 16); }
__device__ __forceinline__ float bfhi(unsigned w) { return __uint_as_float(w & 0xffff0000u); }
__device__ __forceinline__ unsigned pk2(float lo, float hi) { return pg8::cvt_pk_bf16(lo, hi); }
#define LDS_WAIT() asm volatile("s_waitcnt lgkmcnt(0)" ::: "memory")

__constant__ unsigned char T5_BUCKET[128] = {0, 1, 2, 3, 4, 5, 6, 7, 8, 9, 10, 11, 12, 13, 14, 15, 16, 16, 16, 17, 17, 18, 18, 18, 19, 19, 19, 20, 20, 20, 20, 21, 21, 21, 21, 22, 22, 22, 22, 22, 23, 23, 23, 23, 23, 23, 24, 24, 24, 24, 24, 24, 25, 25, 25, 25, 25, 25, 25, 26, 26, 26, 26, 26, 26, 26, 26, 27, 27, 27, 27, 27, 27, 27, 27, 27, 27, 28, 28, 28, 28, 28, 28, 28, 28, 28, 28, 29, 29, 29, 29, 29, 29, 29, 29, 29, 29, 29, 29, 30, 30, 30, 30, 30, 30, 30, 30, 30, 30, 30, 30, 30, 30, 31, 31, 31, 31, 31, 31, 31, 31, 31, 31, 31, 31, 31, 31, 31};

__device__ __forceinline__ void p0_transpose_item(const float* W, int K, int N, bf16_t* WT, const float* gain, int swz, LAS float* scr, int item, int lane, int ldk = 0, int koff = 0) {
    if (ldk == 0) ldk = K;
    const int nblk = N / 32, kb = item / nblk, nb = item % nblk, k0 = 64 * kb, n0 = 32 * nb;
    int drow0 = n0;
    if (swz == 1) { const int up = n0 >= DFF ? 1 : 0; const int j = n0 - up * DFF; drow0 = 256 * (j >> 7) + (j & 127) + 128 * up; }
    if (swz == 2 && n0 >= 2816) { const int up = n0 >= 3840 ? 1 : 0; const int j = n0 - 2816 - up * 1024; drow0 = 2816 + 256 * (j >> 7) + (j & 127) + 128 * up; }
#pragma unroll
    for (int i = 0; i < 32; ++i) { const int kk = 2 * i + (lane >> 5); const float g = gain ? gain[k0 + kk] : 1.0f; scr[kk * 33 + (lane & 31)] = __builtin_nontemporal_load(W + (size_t)(k0 + kk) * N + n0 + (lane & 31)) * g; }
    LDS_WAIT(); asm volatile("" ::: "memory");
    const int c = lane & 7;
#pragma unroll
    for (int j = 0; j < 4; ++j) { const int n = (lane >> 3) + 8 * j; const LAS float* s = scr + (8 * c) * 33 + n;
        u32x4 o; o.x = pk2(s[0 * 33], s[1 * 33]); o.y = pk2(s[2 * 33], s[3 * 33]); o.z = pk2(s[4 * 33], s[5 * 33]); o.w = pk2(s[6 * 33], s[7 * 33]);
        *(u32x4*)(WT + (size_t)(drow0 + n) * ldk + koff + k0 + 8 * c) = o; }
    LDS_WAIT(); asm volatile("" ::: "memory");
}

struct Args { const float* in[21]; float* out; unsigned char* ws; };

__device__ __forceinline__ void p0_prologue(const Args& a, LAS unsigned char* lds, int tid, int lane, int wave, int G) {
    unsigned char* ws = a.ws;
    LAS float* scr = (LAS float*)(lds + wave * 16384);
    const int gw = blockIdx.x * 8 + wave, NGW = G * 8;
    constexpr int I1 = 16 * 176, I2 = 44 * 32, I3 = 16 * 152, I4 = 8 * 32, I6 = 16 * 32, I10 = 4 * 32;
    constexpr int NITEMS = I1 + I2 + I3 + I4 + I4 + I6 + I1 + I2 + I6 + I10;
    float* ss = (float*)(ws + WS_SS);
    bf16_t* HB = (bf16_t*)(ws + WS_HB);
    for (int pass = 0; pass < 2; ++pass) {
    if ((pass ^ (wave & 1)) == 0) {
    for (int it = gw; it < NITEMS; it += NGW) {
        int r = it;
        if (r < I1) { p0_transpose_item(a.in[5], 1024, 5632, (bf16_t*)(ws + WS_W1IN), a.in[4], 1, scr, r, lane); continue; } r -= I1;
        if (r < I2) { p0_transpose_item(a.in[6], 2816, 1024, (bf16_t*)(ws + WS_W1OUT), nullptr, 0, scr, r, lane); continue; } r -= I2;
        if (r < I3) { p0_transpose_item(a.in[8], 1024, 4864, (bf16_t*)(ws + WS_WIN), a.in[7], 2, scr, r, lane); continue; } r -= I3;
        if (r < I4) { p0_transpose_item(a.in[11], 512, 1024, (bf16_t*)(ws + WS_WATT), nullptr, 0, scr, r, lane, 1024, 0); continue; } r -= I4;
        if (r < I4) { p0_transpose_item(a.in[12], 512, 1024, (bf16_t*)(ws + WS_WATT), nullptr, 0, scr, r, lane, 1024, 512); continue; } r -= I4;
        if (r < I6) { p0_transpose_item(a.in[13], 1024, 1024, (bf16_t*)(ws + WS_WOUT), nullptr, 0, scr, r, lane); continue; } r -= I6;
        if (r < I1) { p0_transpose_item(a.in[15], 1024, 5632, (bf16_t*)(ws + WS_W2IN), a.in[14], 1, scr, r, lane); continue; } r -= I1;
        if (r < I2) { p0_transpose_item(a.in[16], 2816, 1024, (bf16_t*)(ws + WS_W2OUT), nullptr, 0, scr, r, lane); continue; } r -= I2;
        if (r < I6) { p0_transpose_item(a.in[18], 1024, 1024, (bf16_t*)(ws + WS_WG), a.in[17], 0, scr, r, lane); continue; } r -= I6;
        p0_transpose_item(a.in[19], 256, 1024, (bf16_t*)(ws + WS_WP), nullptr, 0, scr, r, lane);
    }
    } else {
    for (int m = gw; m < MTOK; m += 4 * NGW) {
        f32x4 v[4][4]; float s[4];
#pragma unroll
        for (int q = 0; q < 4; ++q) { const int mq = (m + q * NGW < MTOK) ? m + q * NGW : m; const f32x4* xr = (const f32x4*)(a.in[0] + (size_t)mq * DM) + lane;
#pragma unroll
            for (int j = 0; j < 4; ++j) v[q][j] = __builtin_nontemporal_load(xr + 64 * j); }
#pragma unroll
        for (int q = 0; q < 4; ++q) { s[q] = 0.f;
#pragma unroll
            for (int j = 0; j < 4; ++j) s[q] += (v[q][j].x * v[q][j].x + v[q][j].y * v[q][j].y) + (v[q][j].z * v[q][j].z + v[q][j].w * v[q][j].w); }
#pragma unroll
        for (int o = 1; o < 64; o <<= 1) {
#pragma unroll
            for (int q = 0; q < 4; ++q) s[q] += __shfl_xor(s[q], o); }
#pragma unroll
        for (int q = 0; q < 4; ++q) { const int mq = m + q * NGW;
            if (mq < MTOK) { u32x2* o8 = (u32x2*)(HB + (size_t)mq * DM) + lane;
#pragma unroll
                for (int j = 0; j < 4; ++j) { u32x2 w; w.x = pk2(v[q][j].x, v[q][j].y); w.y = pk2(v[q][j].z, v[q][j].w); o8[64 * j] = w; }
                if (lane == 0) *(f32x4*)(ss + (size_t)mq * 4) = (f32x4){s[q], 0.f, 0.f, 0.f}; } }
    }
    }
    }
    const int gt = blockIdx.x * 512 + tid, NGT = G * 512;
    bf16_t* PB = (bf16_t*)(ws + WS_PB);
    for (int i = gt; i < MTOK * PLE / 8; i += 4 * NGT) {
        f32x4 p0[4], p1[4];
#pragma unroll
        for (int q = 0; q < 4; ++q) { const int iq = (i + q * NGT < MTOK * PLE / 8) ? i + q * NGT : i; p0[q] = __builtin_nontemporal_load((const f32x4*)a.in[1] + 2 * iq); p1[q] = __builtin_nontemporal_load((const f32x4*)a.in[1] + 2 * iq + 1); }
#pragma unroll
        for (int q = 0; q < 4; ++q) { const int iq = i + q * NGT;
            if (iq < MTOK * PLE / 8) { u32x4 w; w.x = pk2(p0[q].x, p0[q].y); w.y = pk2(p0[q].z, p0[q].w); w.z = pk2(p1[q].x, p1[q].y); w.w = pk2(p1[q].z, p1[q].w); ((u32x4*)PB)[iq] = w; } }
    }
}


struct PartOrder {
    pg8::StaticOrder S; int pm0;
    __device__ void init(int Mpart, int N, int G, int c, int pm0_) { S.init(Mpart, N, G, c); pm0 = pm0_; }
    __device__ bool next(int i, pg8::Unit& u) const { const bool r = S.next(i, u); u.pm += pm0; return r; }
    __device__ __forceinline__ void a_ready(const pg8::Unit&) const {}
    __device__ __forceinline__ void done(const pg8::Unit&) const {}
};

struct RevOrder {
    pg8::StaticOrder S; int nr;
    __device__ void init(int M, int N, int G, int c) { S.init(M, N, G, c); nr = (S.nwg + G - 1) / G; }
    __device__ bool next(int i, pg8::Unit& u) const { if (i >= nr) return false; return S.next(nr - 1 - i, u); }
    __device__ __forceinline__ void a_ready(const pg8::Unit&) const {}
    __device__ __forceinline__ void done(const pg8::Unit&) const {}
};
#define XB_TMO      128
#define XB_XCNT(j)  (256  + 64 * (j))
#define XB_XSUB(j)  (1280 + 64 * (j))
#define XB_XGEN(j)  (2304 + 64 * (j))
#define XB_TOP      3328
#define XB_TOPGEN   3392
#define XCD_BAR_WORDS 3456
#define XB_SPIN_CAP (1u << 18)

__device__ __forceinline__ unsigned xb_ld(unsigned* p)              { return __hip_atomic_load(p, __ATOMIC_RELAXED, __HIP_MEMORY_SCOPE_AGENT); }
__device__ __forceinline__ unsigned xb_add(unsigned* p, unsigned v) { return __hip_atomic_fetch_add(p, v, __ATOMIC_RELAXED, __HIP_MEMORY_SCOPE_AGENT); }
__device__ __forceinline__ unsigned xb_xcc_id() { return (unsigned)__builtin_amdgcn_s_getreg((3 << 11) | 20) & 0xFu; }
#define XB_SPIN(cond, bar) do { unsigned _sp = 0; while (cond) { __builtin_amdgcn_s_sleep(1); \
    if ((++_sp & 255u) == 0u) { if (xb_ld(&(bar)[XB_TMO])) break; if (_sp > XB_SPIN_CAP) { atomicAdd(&(bar)[XB_TMO], 1u); break; } } } } while (0)

struct XcdBarrier {
    unsigned* bar; unsigned x;
    volatile LAS unsigned* st;
};

__device__ __forceinline__ XcdBarrier xcd_barrier_post(unsigned* bar, volatile LAS unsigned* st) {
    XcdBarrier b; b.bar = bar; b.x = xb_xcc_id(); b.st = st;
    if (threadIdx.x == 0) (void)xb_add(&bar[XB_XCNT(b.x)], 1u);
    return b;
}
__device__ __forceinline__ void xcd_barrier_complete(unsigned* bar, unsigned x, unsigned& nloc, unsigned& nx) {
    const unsigned G = gridDim.x * gridDim.y * gridDim.z;
    unsigned sum, cnt, mine, sp = 0u;
    for (;;) {
        sum = 0u; cnt = 0u; mine = 0u;
#pragma unroll
        for (unsigned j = 0; j < 16; ++j) { const unsigned c = xb_ld(&bar[XB_XCNT(j)]); sum += c; cnt += (c > 0u) ? 1u : 0u; mine = (j == x) ? c : mine; }
        if (sum == G) break;
        __builtin_amdgcn_s_sleep(1);
        if ((++sp & 255u) == 0u) { if (xb_ld(&bar[XB_TMO])) break; if (sp > XB_SPIN_CAP) { atomicAdd(&bar[XB_TMO], 1u); break; } }
    }
    nloc = mine > 0u ? mine : 1u; nx = cnt > 0u ? cnt : 1u;
}

__device__ __forceinline__ void xcd_barrier(const XcdBarrier& b) {
    asm volatile("s_waitcnt vmcnt(0)" ::: "memory");
    __syncthreads();
    if (threadIdx.x == 0) {
        unsigned* bar = b.bar;
        __builtin_amdgcn_s_waitcnt(0);
        unsigned nloc = b.st[0], nx = b.st[1];
        if (nloc == 0u) { xcd_barrier_complete(bar, b.x, nloc, nx); b.st[0] = nloc; b.st[1] = nx; }
        const unsigned old = xb_add(&bar[XB_XSUB(b.x)], 1u);
        const unsigned gen = old / nloc;
        if (old + 1u == (gen + 1u) * nloc) {
            __builtin_amdgcn_fence(__ATOMIC_RELEASE, "agent");
            asm volatile("s_waitcnt vmcnt(0)" ::: "memory");
            const unsigned og = xb_add(&bar[XB_TOP], 1u);
            const unsigned tg = og / nx;
            if (og + 1u == (tg + 1u) * nx) xb_add(&bar[XB_TOPGEN], 1u);
            else XB_SPIN(xb_ld(&bar[XB_TOPGEN]) == tg, bar);
            __builtin_amdgcn_fence(__ATOMIC_ACQUIRE, "agent");
            xb_add(&bar[XB_XGEN(b.x)], 1u);
            asm volatile("s_waitcnt vmcnt(0)" ::: "memory");
        } else {
            XB_SPIN(xb_ld(&bar[XB_XGEN(b.x)]) == gen, bar);
            __builtin_amdgcn_fence(__ATOMIC_ACQUIRE, "agent");
            asm volatile("s_waitcnt vmcnt(0)" ::: "memory");
        }
    }
    __syncthreads();
}

__device__ __forceinline__ void xcd_group_barrier(const XcdBarrier& b) {
    asm volatile("s_waitcnt vmcnt(0)" ::: "memory");
    __syncthreads();
    if (threadIdx.x == 0) {
        unsigned* bar = b.bar;
        __builtin_amdgcn_s_waitcnt(0);
        unsigned nloc = b.st[0], nx = b.st[1];
        if (nloc == 0u) { xcd_barrier_complete(bar, b.x, nloc, nx); b.st[0] = nloc; b.st[1] = nx; }
        const unsigned old = xb_add(&bar[XB_XSUB(b.x)], 1u);
        const unsigned gen = old / nloc;
        if (old + 1u == (gen + 1u) * nloc) xb_add(&bar[XB_XGEN(b.x)], 1u);
        else XB_SPIN(xb_ld(&bar[XB_XGEN(b.x)]) == gen, bar);
        __builtin_amdgcn_fence(__ATOMIC_ACQUIRE, "agent");
        asm volatile("s_waitcnt vmcnt(0)" ::: "memory");
    }
    __syncthreads();
}
typedef short bf16x8 __attribute__((ext_vector_type(8)));
typedef float f32x16 __attribute__((ext_vector_type(16)));
typedef float f32x2_t __attribute__((ext_vector_type(2)));
typedef __bf16 bf16x2_t __attribute__((ext_vector_type(2)));
__device__ __forceinline__ unsigned cvtpk_s(float lo, float hi) { f32x2_t v = {lo, hi}; bf16x2_t b = __builtin_convertvector(v, bf16x2_t); return __builtin_bit_cast(unsigned, b); }
__device__ __forceinline__ float ex(float x) { return __builtin_amdgcn_exp2f(x * 1.44269504f); }
#define LBAR() asm volatile("s_waitcnt lgkmcnt(0)\n\ts_barrier" ::: "memory")
#define MFMA32(a, b, c) __builtin_amdgcn_mfma_f32_32x32x16_bf16((a), (b), (c), 0, 0, 0)
__device__ __forceinline__ int crow(int r, int hi) { return (r & 3) + 8 * (r >> 2) + 4 * hi; }
__device__ __forceinline__ bf16x8 pack8(const f32x16& x, int s) {
    u32x4 p; p.x = cvtpk_s(x[8 * s], x[8 * s + 1]); p.y = cvtpk_s(x[8 * s + 2], x[8 * s + 3]); p.z = cvtpk_s(x[8 * s + 4], x[8 * s + 5]); p.w = cvtpk_s(x[8 * s + 6], x[8 * s + 7]);
    return __builtin_bit_cast(bf16x8, p);
}
__device__ __forceinline__ bf16x8 ld2x8(const LAS unsigned char* p) {
    const u32x2 lo = *(const LAS u32x2*)p, hi = *(const LAS u32x2*)(p + 16);
    u32x4 v; v.x = lo.x; v.y = lo.y; v.z = hi.x; v.w = hi.y; return __builtin_bit_cast(bf16x8, v);
}

__device__ __forceinline__ void attn_mfma_units(LAS unsigned char* lds, int u0, int ustride, int nunits, const bf16_t* Q, const bf16_t* Kb, const bf16_t* VT, const float* relb, const float* sinks, bf16_t* ATT, int tid) {
    constexpr int KP = 144, VP = 520;
    constexpr float LOG2E = 1.44269504f;
    LAS unsigned char* Ks = lds; LAS unsigned char* Vs = lds + 256 * KP; LAS float* ext = (LAS float*)(lds + 256 * KP + 64 * VP);
    const int lane = tid & 63, wv = tid >> 6, g = wv >> 1, l32 = lane & 31, hi = lane >> 5;
    const int skey = tid >> 1, shalf = tid & 1, sd = tid >> 3, sseg = tid & 7;
    u32x4 kw[4], vw[4];
#define AT_LOAD(u_) do { const int b_ = (u_) >> 5, n_ = ((u_) >> 1) & 15, hk_ = (u_) & 1; \
        const int kpos_ = n_ * 128 - 128 + skey, vpos_ = n_ * 128 - 128 + sseg * 32; \
        const u32x4* ks_ = (const u32x4*)(Kb + (size_t)(b_ * SEQL + (kpos_ < 0 ? 0 : kpos_)) * 128 + hk_ * 64 + shalf * 32); \
        const u32x4* vs_ = (const u32x4*)(VT + ((size_t)((b_ * 2 + hk_) * 64 + sd) << 11) + (vpos_ < 0 ? 0 : vpos_)); \
        _Pragma("unroll") for (int i = 0; i < 4; ++i) { kw[i] = ks_[i]; vw[i] = vs_[i]; } \
        if (kpos_ < 0) { _Pragma("unroll") for (int i = 0; i < 4; ++i) kw[i] = (u32x4){0u, 0u, 0u, 0u}; } \
        if (vpos_ < 0) { _Pragma("unroll") for (int i = 0; i < 4; ++i) vw[i] = (u32x4){0u, 0u, 0u, 0u}; } } while (0)
    if (u0 < nunits) AT_LOAD(u0);
    for (int unit = u0; unit < nunits; unit += ustride) {
        const int b = unit >> 5, n = (unit >> 1) & 15, hk = unit & 1, head = hk * 4 + g;
        {   LAS u32x4* d = (LAS u32x4*)(Ks + skey * KP + shalf * 64);
#pragma unroll
            for (int i = 0; i < 4; ++i) d[i] = kw[i];
            LAS u32x2* dd = (LAS u32x2*)(Vs + sd * VP + sseg * 64);
#pragma unroll
            for (int i = 0; i < 4; ++i) { u32x2 a; a.x = vw[i].x; a.y = vw[i].y; u32x2 c; c.x = vw[i].z; c.y = vw[i].w; dd[2 * i] = a; dd[2 * i + 1] = c; }
            for (int i = tid; i < 4 * 192; i += 512) { const int gg = i / 192, dist = i % 192 - 32;
                ext[i] = (dist >= 0 && dist < 128) ? relb[(int)T5_BUCKET[dist & 127] * 8 + hk * 4 + gg] * LOG2E : -INFINITY; }
        }
        bf16x8 qc[2][4];
#pragma unroll
        for (int sb = 0; sb < 2; ++sb) { const size_t row_ = (size_t)b * SEQL + n * 128 + 32 * (2 * (wv & 1) + sb) + l32;
#pragma unroll
            for (int ds = 0; ds < 4; ++ds) qc[sb][ds] = *(const bf16x8*)(Q + row_ * 512 + head * 64 + 16 * ds + 8 * hi); }
        LBAR();
        if (unit + ustride < nunits) AT_LOAD(unit + ustride);
        const float sink = sinks[head] * LOG2E;
        const LAS float* ex0 = ext + g * 192 + l32 - 4 * hi;
#pragma unroll
        for (int sb = 0; sb < 2; ++sb) {
            const int a = 2 * (wv & 1) + sb;
            const size_t row = (size_t)b * SEQL + n * 128 + 32 * a + l32;
            f32x16 S[5];
            {   bf16x8 kfr[2][4];
#pragma unroll
                for (int ds = 0; ds < 4; ++ds) kfr[0][ds] = *(const LAS bf16x8*)(Ks + (32 * a + l32) * KP + (16 * ds + 8 * hi) * 2);
#pragma unroll
                for (int t = 0; t < 5; ++t) {
                    if (t + 1 < 5) {
#pragma unroll
                        for (int ds = 0; ds < 4; ++ds) kfr[(t + 1) & 1][ds] = *(const LAS bf16x8*)(Ks + (32 * (a + t + 1) + l32) * KP + (16 * ds + 8 * hi) * 2);
                    }
                    f32x16 acc;
#pragma unroll
                    for (int r = 0; r < 16; ++r) acc[r] = 0.f;
#pragma unroll
                    for (int ds = 0; ds < 4; ++ds) acc = MFMA32(kfr[t & 1][ds], qc[sb][ds], acc);
                    S[t] = acc;
                }
            }
            float mx = sink;
#pragma unroll
            for (int t = 0; t < 5; ++t) {
                const bool dead = (n == 0) && (a + t < 4);
#pragma unroll
                for (int r = 0; r < 16; ++r) {
                    float sv = __builtin_fmaf(S[t][r], LOG2E, ex0[160 - 32 * t - (r & 3) - 8 * (r >> 2)]);
                    sv = dead ? -INFINITY : sv;
                    S[t][r] = sv; mx = fmaxf(mx, sv);
                }
            }
            mx = fmaxf(mx, __shfl_xor(mx, 32));
            float l = 0.f;
#pragma unroll
            for (int t = 0; t < 5; ++t)
#pragma unroll
                for (int r = 0; r < 16; ++r) { const float p = __builtin_amdgcn_exp2f(S[t][r] - mx); S[t][r] = p; l += p; }
            l += __shfl_xor(l, 32); l += __builtin_amdgcn_exp2f(sink - mx);
            f32x16 O[2];
#pragma unroll
            for (int dt = 0; dt < 2; ++dt)
#pragma unroll
                for (int r = 0; r < 16; ++r) O[dt][r] = 0.f;
            {   bf16x8 vfr[2][4];
#pragma unroll
                for (int i = 0; i < 4; ++i) vfr[0][i] = ld2x8(Vs + (l32 + 32 * (i & 1)) * VP + (32 * a + 16 * (i >> 1) + 4 * hi) * 2);
#pragma unroll
                for (int t = 0; t < 5; ++t) {
                    if (t + 1 < 5) {
#pragma unroll
                        for (int i = 0; i < 4; ++i) vfr[(t + 1) & 1][i] = ld2x8(Vs + (l32 + 32 * (i & 1)) * VP + (32 * (a + t + 1) + 16 * (i >> 1) + 4 * hi) * 2);
                    }
#pragma unroll
                    for (int kb = 0; kb < 2; ++kb) {
                        const bf16x8 pf = pack8(S[t], kb);
#pragma unroll
                        for (int dt = 0; dt < 2; ++dt) O[dt] = MFMA32(vfr[t & 1][2 * kb + dt], pf, O[dt]);
                    }
                }
            }
            const float rl = 1.0f / l;
#pragma unroll
            for (int dt = 0; dt < 2; ++dt)
#pragma unroll
                for (int c4 = 0; c4 < 4; ++c4) {
                    u32x2 w; w.x = cvtpk_s(O[dt][4 * c4] * rl, O[dt][4 * c4 + 1] * rl); w.y = cvtpk_s(O[dt][4 * c4 + 2] * rl, O[dt][4 * c4 + 3] * rl);
                    *(u32x2*)(ATT + row * 1024 + head * 64 + 32 * dt + 8 * c4 + 4 * hi) = w;
                }
            asm volatile("" ::: "memory");
        }
        LBAR();
    }
#undef AT_LOAD
}

__device__ __forceinline__ void rec_mfma_unit(LAS unsigned char* lds, int unit, const bf16_t* RQ, const bf16_t* RG, const bf16_t* RIT, const bf16_t* SG, const float* recnorm, bf16_t* REC, int tid) {
    constexpr int PQ = 272, PK = 144;
    LAS unsigned char* QT = lds;
    LAS unsigned char* KT = lds + 17408;
    LAS unsigned char* KH = lds + 34816;
    LAS unsigned char* VS = lds + 53248;
    LAS unsigned char* ST = lds + 71680;
    LAS float* GM = (LAS float*)(lds + 106496);
    LAS float* SEG = (LAS float*)(lds + 107008);
    LAS float* PSS = (LAS float*)(lds + 111104);
    LAS float* GN = (LAS float*)(lds + 129536);
    LAS unsigned char* OT = lds + 112128;
    const int b = unit >> 2, h = unit & 3;
    const int lane = tid & 63, wv = tid >> 6, l32 = lane & 31, hi = lane >> 5;
    const size_t R0 = (size_t)b * SEQL;
    const int cp = lane, tseg = wv;
    const bf16_t* gsrc = RG + (R0 + 8 * tseg) * 512 + h * 128 + 2 * cp;
    const bf16_t* qsrc = RQ + (R0 + 8 * tseg) * 512 + h * 128 + 2 * cp;
    const int vdv = tid >> 2, vpart = tid & 3;
    const bf16_t* vsrc = RIT + (((size_t)((b * 4 + h) * 128 + vdv)) << 11) + vpart * 16;
    const int dvi = wv >> 1, tj = ((wv >> 2) ^ wv) & 1;
    const int di = wv >> 1, dj0 = 2 * (wv & 1);
    const int trow = 32 * tj + l32;
    const int wt = tid >> 3, wp = tid & 7;
    const size_t woff = (R0 + wt) * 512 + h * 128 + wp * 16;
    const size_t roff = (R0 + wt) * 1024 + 512 + h * 128 + wp * 16;
    f32x16 SA[2];
#pragma unroll
    for (int x = 0; x < 2; ++x)
#pragma unroll
        for (int r = 0; r < 16; ++r) SA[x][r] = 0.f;
    if (tid < 128) GN[tid] = recnorm[tid];
    unsigned gw[8], qw[8]; u32x4 vw[2]; u32x4 sgw[2];
    sgw[0] = (u32x4){0u, 0u, 0u, 0u}; sgw[1] = sgw[0];
#pragma unroll
    for (int tt = 0; tt < 8; ++tt) { gw[tt] = *(const unsigned*)(gsrc + tt * 512); qw[tt] = *(const unsigned*)(qsrc + tt * 512); }
    vw[0] = *(const u32x4*)(vsrc); vw[1] = *(const u32x4*)(vsrc + 8);
#define REC_WRITEOUT(cc) do { const LAS u32x4* op_ = (const LAS u32x4*)(OT + wt * PQ + wp * 32); \
        _Pragma("unroll") for (int i_ = 0; i_ < 2; ++i_) { const u32x4 ov_ = op_[i_]; f32x4 a0_, a1_, s0_, s1_; \
            a0_ = (f32x4){bflo(ov_.x), bfhi(ov_.x), bflo(ov_.y), bfhi(ov_.y)}; a1_ = (f32x4){bflo(ov_.z), bfhi(ov_.z), bflo(ov_.w), bfhi(ov_.w)}; \
            s0_ = (f32x4){bflo(sgw[i_].x), bfhi(sgw[i_].x), bflo(sgw[i_].y), bfhi(sgw[i_].y)}; s1_ = (f32x4){bflo(sgw[i_].z), bfhi(sgw[i_].z), bflo(sgw[i_].w), bfhi(sgw[i_].w)}; \
            a0_ = a0_ * s0_; a1_ = a1_ * s1_; u32x4 w_; w_.x = cvtpk_s(a0_[0], a0_[1]); w_.y = cvtpk_s(a0_[2], a0_[3]); w_.z = cvtpk_s(a1_[0], a1_[1]); w_.w = cvtpk_s(a1_[2], a1_[3]); \
            *(u32x4*)(REC + roff + (size_t)(cc) * 64 * 1024 + 8 * i_) = w_; } } while (0)
    for (int c = 0; c < 32; ++c) {
        f32x2_t fv[8], cpv[8]; f32x2_t run = {1.f, 1.f};
#pragma unroll
        for (int tt = 0; tt < 8; ++tt) { fv[tt].x = ex(bflo(gw[tt])); fv[tt].y = ex(bfhi(gw[tt])); run = run * fv[tt]; cpv[tt] = run; }
        *(LAS f32x2_t*)(SEG + tseg * 128 + 2 * cp) = run;
        LBAR();
        if (c > 0) REC_WRITEOUT(c - 1);
        f32x2_t pre = {1.f, 1.f}, tot = {1.f, 1.f};
#pragma unroll
        for (int s = 0; s < 8; ++s) { const f32x2_t v = *(const LAS f32x2_t*)(SEG + s * 128 + 2 * cp); tot = tot * v; if (s < tseg) pre = pre * v; }
        f32x2_t kh[8];
#pragma unroll
        for (int tt = 0; tt < 8; ++tt) {
            const f32x2_t E = pre * cpv[tt];
            f32x2_t rE; rE.x = fminf(__builtin_amdgcn_rcpf(E.x), 5.5e34f); rE.y = fminf(__builtin_amdgcn_rcpf(E.y), 5.5e34f);
            const f32x2_t k = 1.0f - fv[tt];
            f32x2_t qv; qv.x = bflo(qw[tt]); qv.y = bfhi(qw[tt]);
            const f32x2_t qt = qv * E, kt = k * rE;
            kh[tt] = k * (tot * rE);
            *(LAS unsigned*)(QT + (8 * tseg + tt) * PQ + 4 * cp) = cvtpk_s(qt.x, qt.y);
            *(LAS unsigned*)(KT + (8 * tseg + tt) * PQ + 4 * cp) = cvtpk_s(kt.x, kt.y);
        }
        { u32x4 w0, w1; w0.x = cvtpk_s(kh[0].x, kh[1].x); w0.y = cvtpk_s(kh[2].x, kh[3].x); w0.z = cvtpk_s(kh[4].x, kh[5].x); w0.w = cvtpk_s(kh[6].x, kh[7].x);
          w1.x = cvtpk_s(kh[0].y, kh[1].y); w1.y = cvtpk_s(kh[2].y, kh[3].y); w1.z = cvtpk_s(kh[4].y, kh[5].y); w1.w = cvtpk_s(kh[6].y, kh[7].y);
          *(LAS u32x4*)(KH + (2 * cp) * PK + 16 * tseg) = w0; *(LAS u32x4*)(KH + (2 * cp + 1) * PK + 16 * tseg) = w1; }
        if (tseg == 0) *(LAS f32x2_t*)(GM + 2 * cp) = tot;
        *(LAS u32x4*)(VS + vdv * PK + vpart * 32) = vw[0]; *(LAS u32x4*)(VS + vdv * PK + vpart * 32 + 16) = vw[1];
        LBAR();
        if (c + 1 < 32) {
            const size_t adv = (size_t)(c + 1) * 64;
#pragma unroll
            for (int tt = 0; tt < 8; ++tt) { gw[tt] = *(const unsigned*)(gsrc + (adv + tt) * 512); qw[tt] = *(const unsigned*)(qsrc + (adv + tt) * 512); }
            vw[0] = *(const u32x4*)(vsrc + adv); vw[1] = *(const u32x4*)(vsrc + adv + 8);
        }
        sgw[0] = *(const u32x4*)(SG + woff + (size_t)c * 64 * 512); sgw[1] = *(const u32x4*)(SG + woff + (size_t)c * 64 * 512 + 8);
        bf16x8 qf[8], kf[8];
#pragma unroll
        for (int ks = 0; ks < 8; ++ks) qf[ks] = *(const LAS bf16x8*)(QT + trow * PQ + (16 * ks + 8 * hi) * 2);
#pragma unroll
        for (int ks = 0; ks < 8; ++ks) kf[ks] = *(const LAS bf16x8*)(KT + l32 * PQ + (16 * ks + 8 * hi) * 2);
        bf16x8 vf[2];
#pragma unroll
        for (int kb = 0; kb < 2; ++kb) vf[kb] = ld2x8(VS + (32 * dvi + l32) * PK + (16 * kb + 4 * hi) * 2);
        f32x16 at0, at1;
#pragma unroll
        for (int r = 0; r < 16; ++r) { at0[r] = 0.f; at1[r] = 0.f; }
#pragma unroll
        for (int ks = 0; ks < 8; ++ks) at0 = MFMA32(kf[ks], qf[ks], at0);
        if (tj) {
#pragma unroll
            for (int ks = 0; ks < 8; ++ks) kf[ks] = *(const LAS bf16x8*)(KT + (32 + l32) * PQ + (16 * ks + 8 * hi) * 2);
#pragma unroll
            for (int ks = 0; ks < 8; ++ks) at1 = MFMA32(kf[ks], qf[ks], at1);
#pragma unroll
            for (int r = 0; r < 16; ++r) at1[r] = (crow(r, hi) <= l32) ? at1[r] : 0.f;
        } else {
#pragma unroll
            for (int r = 0; r < 16; ++r) at0[r] = (crow(r, hi) <= l32) ? at0[r] : 0.f;
        }
        if (c > 0) {
#pragma unroll
            for (int ks = 0; ks < 8; ++ks) kf[ks] = *(const LAS bf16x8*)(ST + (32 * dvi + l32) * PQ + (16 * ks + 8 * hi) * 2);
        }
        f32x16 oacc;
#pragma unroll
        for (int r = 0; r < 16; ++r) oacc[r] = 0.f;
#pragma unroll
        for (int kb = 0; kb < 2; ++kb) { const bf16x8 pf = pack8(at0, kb); oacc = MFMA32(vf[kb], pf, oacc); }
        if (tj) {
            bf16x8 vg[2];
#pragma unroll
            for (int kb = 0; kb < 2; ++kb) vg[kb] = ld2x8(VS + (32 * dvi + l32) * PK + (32 + 16 * kb + 4 * hi) * 2);
#pragma unroll
            for (int kb = 0; kb < 2; ++kb) { const bf16x8 pf = pack8(at1, kb); oacc = MFMA32(vg[kb], pf, oacc); }
        }
        if (c > 0) {
#pragma unroll
            for (int ks = 0; ks < 8; ++ks) oacc = MFMA32(kf[ks], qf[ks], oacc);
        }
        { float ps = 0.f;
#pragma unroll
          for (int r = 0; r < 16; ++r) ps += oacc[r] * oacc[r];
          ps += __shfl_xor(ps, 32);
          if (hi == 0) PSS[dvi * 64 + trow] = ps; }
        LBAR();
        {   const float tot2 = (PSS[trow] + PSS[64 + trow]) + (PSS[128 + trow] + PSS[192 + trow]);
            const float rinv = __builtin_amdgcn_rsqf(tot2 * (1.0f / 128.0f) + 1e-6f);
#pragma unroll
            for (int c4 = 0; c4 < 4; ++c4) {
                const f32x4 gnv = *(const LAS f32x4*)(GN + 32 * dvi + 8 * c4 + 4 * hi);
                u32x2 w; w.x = cvtpk_s(oacc[4 * c4] * rinv * gnv[0], oacc[4 * c4 + 1] * rinv * gnv[1]); w.y = cvtpk_s(oacc[4 * c4 + 2] * rinv * gnv[2], oacc[4 * c4 + 3] * rinv * gnv[3]);
                *(LAS u32x2*)(OT + trow * PQ + (32 * dvi + 8 * c4 + 4 * hi) * 2) = w;
            }
        }
#pragma unroll
        for (int c4 = 0; c4 < 4; ++c4) { const f32x4 gm = *(const LAS f32x4*)(GM + 32 * di + 8 * c4 + 4 * hi);
#pragma unroll
            for (int x = 0; x < 2; ++x)
#pragma unroll
                for (int j = 0; j < 4; ++j) SA[x][4 * c4 + j] *= gm[j]; }
        { bf16x8 af[4], bv[2][4];
#pragma unroll
          for (int ks = 0; ks < 4; ++ks) { af[ks] = *(const LAS bf16x8*)(KH + (32 * di + l32) * PK + (16 * ks + 8 * hi) * 2);
#pragma unroll
              for (int x = 0; x < 2; ++x) bv[x][ks] = *(const LAS bf16x8*)(VS + (32 * (dj0 + x) + l32) * PK + (16 * ks + 8 * hi) * 2); }
#pragma unroll
          for (int ks = 0; ks < 4; ++ks)
#pragma unroll
              for (int x = 0; x < 2; ++x) SA[x] = MFMA32(af[ks], bv[x][ks], SA[x]); }
#pragma unroll
        for (int x = 0; x < 2; ++x)
#pragma unroll
            for (int c4 = 0; c4 < 4; ++c4) { u32x2 w; w.x = cvtpk_s(SA[x][4 * c4], SA[x][4 * c4 + 1]); w.y = cvtpk_s(SA[x][4 * c4 + 2], SA[x][4 * c4 + 3]);
                *(LAS u32x2*)(ST + (32 * (dj0 + x) + l32) * PQ + (32 * di + 8 * c4 + 4 * hi) * 2) = w; }
    }
    LBAR();
    REC_WRITEOUT(31);
    LBAR();
#undef REC_WRITEOUT
}

#define ATTN_UNIT attn_mfma_unit
#define REC_UNIT rec_mfma_unit
__global__ void __launch_bounds__(512, 2) fwd_megakernel(Args a) {
    extern __shared__ __attribute__((aligned(16))) unsigned char lds_raw[];
    LAS unsigned char* lds = (LAS unsigned char*)lds_raw;
    cg::grid_group grid = cg::this_grid();
    const int G = gridDim.x, bx = blockIdx.x;
#define FRESH_TID() int tid_ = threadIdx.x; asm volatile("" : "+v"(tid_)); const int tid = tid_, lane = tid & 63, wave = __builtin_amdgcn_readfirstlane(tid >> 6); (void)lane; (void)wave
    unsigned char* ws = a.ws;
    float* ss0 = (float*)(ws + WS_SS); float* ss1 = ss0 + 4 * MTOK; float* ss2 = ss1 + 4 * MTOK; float* ss3 = ss2 + 4 * MTOK; float* ss4 = ss3 + 4 * MTOK;
    bf16_t* HB = (bf16_t*)(ws + WS_HB); bf16_t* PB = (bf16_t*)(ws + WS_PB); bf16_t* ATT = (bf16_t*)(ws + WS_ATT); bf16_t* REC = (bf16_t*)(ws + WS_ATT);
    bf16_t* ACT = (bf16_t*)(ws + WS_ACT); bf16_t* MG = (bf16_t*)(ws + WS_MG); bf16_t* TPB = (bf16_t*)a.out;     bf16_t* H4B = (bf16_t*)(ws + WS_ATT);
    bf16_t* Qb = (bf16_t*)(ws + WS_Q); bf16_t* Kb = (bf16_t*)(ws + WS_K); bf16_t* VT = (bf16_t*)(ws + WS_VT); bf16_t* RQ = (bf16_t*)(ws + WS_RQ); bf16_t* RG = (bf16_t*)(ws + WS_RG);
    bf16_t* RIT = (bf16_t*)(ws + WS_RIT); bf16_t* SG = (bf16_t*)(ws + WS_SG); bf16_t* GA = (bf16_t*)(ws + WS_GA); bf16_t* GB = (bf16_t*)(ws + WS_GB);
    float* out = a.out;
    using pg8::Gemm; using pg8::StaticOrder; using pg8::gemm_phase;
    volatile LAS unsigned* MISC = (volatile LAS unsigned*)(lds + MISC_OFF);
    if (threadIdx.x < 32) MISC[threadIdx.x] = 0u;
    __syncthreads();
    const XcdBarrier xbar = xcd_barrier_post((unsigned*)(ws + WS_BAR), MISC + 8);

    { FRESH_TID(); p0_prologue(a, lds, tid, lane, wave, G); }
    grid.sync();

    { Gemm g{HB, (const bf16_t*)(ws + WS_W1IN), MTOK, 2 * DFF, DM}; StaticOrder S; S.init(MTOK, 2 * DFF, G, bx); pg8::EpiSwiglu E{ACT, ss0};
      gemm_phase<pg8::EpiSwiglu, StaticOrder, true, true>(lds, g, S, E); }
    xcd_barrier(xbar);
    { Gemm g{ACT, (const bf16_t*)(ws + WS_W1OUT), MTOK, DM, DFF}; StaticOrder S; S.init(MTOK, DM, G, bx); pg8::EpiRes<true> E{a.in[0], HB, ss1, 0.5f};
      gemm_phase<pg8::EpiRes<true>, StaticOrder, true, true>(lds, g, S, E); }
    xcd_barrier(xbar);
    { Gemm g{HB, (const bf16_t*)(ws + WS_WIN), MTOK, INW, DM}; StaticOrder S; S.init(MTOK, INW, G, bx); pg8::EpiWin E{ss1, a.in[3], Qb, Kb, VT, RQ, RG, RIT, SG, GA, GB};
      gemm_phase<pg8::EpiWin, StaticOrder, true, true>(lds, g, S, E); }
    xcd_barrier(xbar);
    {
        const int nrec = (G >= 256) ? 128 : G / 2;
        if (bx < nrec) { FRESH_TID(); for (int u = bx; u < NBATCH * 4; u += nrec) REC_UNIT(lds, u, RQ, RG, RIT, SG, a.in[10], REC, tid); }
        if (bx >= nrec) {
            const int na = G - nrec;
            { FRESH_TID();
            attn_mfma_units(lds, bx - nrec, na, NBATCH * 16 * 2, Qb, Kb, VT, a.in[2], a.in[9], ATT, tid); }
            Gemm g{PB, (const bf16_t*)(ws + WS_WP), MTOK, DM, PLE}; StaticOrder S; S.init(MTOK, DM, na, bx - nrec); pg8::EpiStoreBf16 E{TPB};
            gemm_phase<pg8::EpiStoreBf16, StaticOrder, true, true>(lds, g, S, E);
        }
    }
    xcd_barrier(xbar);
    { Gemm g{ATT, (const bf16_t*)(ws + WS_WATT), MTOK, DM, DM}; StaticOrder S; S.init(MTOK, DM, G, bx); pg8::EpiMerge E{GA, GB, MG};
      gemm_phase<pg8::EpiMerge, StaticOrder, true, true>(lds, g, S, E); }
    xcd_barrier(xbar);
    { Gemm g{MG, (const bf16_t*)(ws + WS_WOUT), MTOK, DM, DM}; StaticOrder S; S.init(MTOK, DM, G, bx); pg8::EpiRes<false> E{nullptr, HB, ss2, 1.0f};
      gemm_phase<pg8::EpiRes<false>, StaticOrder, true, true>(lds, g, S, E); }
    xcd_barrier(xbar);
    { Gemm g{HB, (const bf16_t*)(ws + WS_W2IN), MTOK, 2 * DFF, DM}; StaticOrder S; S.init(MTOK, 2 * DFF, G, bx); pg8::EpiSwiglu E{ACT, ss2};
      gemm_phase<pg8::EpiSwiglu, StaticOrder, true, true>(lds, g, S, E); }
    xcd_barrier(xbar);
    { Gemm g{ACT, (const bf16_t*)(ws + WS_W2OUT), MTOK, DM, DFF}; StaticOrder S; S.init(MTOK, DM, G, bx); pg8::EpiRes<false> E{nullptr, HB, ss3, 0.5f};
      gemm_phase<pg8::EpiRes<false>, StaticOrder, true, true>(lds, g, S, E); }
    xcd_barrier(xbar);
    { Gemm g{HB, (const bf16_t*)(ws + WS_WG), MTOK, DM, DM}; StaticOrder S; S.init(MTOK, DM, G, bx); pg8::EpiPle2 E{ss3, TPB, HB, H4B, ss4};
      gemm_phase<pg8::EpiPle2, StaticOrder, true, true>(lds, g, S, E); }
    xcd_barrier(xbar);
    {
        FRESH_TID();
        const int gw = bx * 8 + wave, NGW = G * 8;
        const f32x4* gf = (const f32x4*)a.in[20] + lane;
        f32x4 gv[4];
#pragma unroll
        for (int j = 0; j < 4; ++j) gv[j] = gf[64 * j];
        for (int m = gw; m < MTOK; m += 4 * NGW) {
            u32x2 w[4][4]; float rin[4];
#pragma unroll
            for (int q = 0; q < 4; ++q) { const int mq = (m + q * NGW < MTOK) ? m + q * NGW : m; const u32x2* hr = (const u32x2*)(H4B + (size_t)mq * DM) + lane;
                { const f32x4 q4 = *(const f32x4*)(ss4 + (size_t)mq * 4); rin[q] = (q4[0] + q4[1]) + (q4[2] + q4[3]); }
#pragma unroll
                for (int j = 0; j < 4; ++j) w[q][j] = __builtin_nontemporal_load(hr + 64 * j); }
#pragma unroll
            for (int q = 0; q < 4; ++q) { const int mq = m + q * NGW;
                if (mq < MTOK) { const float rinv = __builtin_amdgcn_rsqf(rin[q] * (1.0f / 1024.0f) + 1e-6f); f32x4* xr = (f32x4*)(out + (size_t)mq * DM) + lane;
#pragma unroll
                    for (int j = 0; j < 4; ++j) { f32x4 v = (f32x4){bflo(w[q][j].x), bfhi(w[q][j].x), bflo(w[q][j].y), bfhi(w[q][j].y)}; v = v * rinv * gv[j]; __builtin_nontemporal_store(v, xr + 64 * j); } } }
        }
    }
}

extern "C" void kernel_launch(void* const* d_in, const int* in_sizes, int n_in, void* d_out, int out_size, void* d_ws, size_t ws_size, hipStream_t stream) {
    static int grid = 0;
    if (grid == 0) {
        int dev = 0, cus = 0, per_cu = 0;
        (void)hipGetDevice(&dev);
        (void)hipDeviceGetAttribute(&cus, hipDeviceAttributeMultiprocessorCount, dev);
        (void)hipFuncSetAttribute((const void*)fwd_megakernel, hipFuncAttributeMaxDynamicSharedMemorySize, LDS_BYTES);
        if (hipOccupancyMaxActiveBlocksPerMultiprocessor(&per_cu, (const void*)fwd_megakernel, 512, LDS_BYTES) != hipSuccess || per_cu < 1) per_cu = 1;
        (void)hipGetLastError();
        if (cus <= 0) cus = 256;
        grid = cus * per_cu;
    }
    (void)hipMemsetAsync((unsigned char*)d_ws + WS_BAR, 0, XCD_BAR_WORDS * 4, stream);
    Args a{};
    for (int i = 0; i < 21; ++i) a.in[i] = (const float*)d_in[i];
    a.out = (float*)d_out; a.ws = (unsigned char*)d_ws;
    void* args[] = {&a};
    hipError_t e = hipLaunchCooperativeKernel((const void*)fwd_megakernel, dim3(grid), dim3(512), args, LDS_BYTES, stream);
    if (e != hipSuccess) fprintf(stderr, "cooperative launch failed: %s (grid %d)\n", hipGetErrorString(e), grid);
}
```

```cpp
#include <hip/hip_runtime.h>
#include <hip/hip_cooperative_groups.h>
#include <cstdio>
#include <cstdint>
namespace cg = cooperative_groups;
namespace pg8 {
#define PG8_LAS __attribute__((address_space(3)))
typedef unsigned short bf16_t;
typedef short bf16x8 __attribute__((ext_vector_type(8)));
typedef float f32x4 __attribute__((ext_vector_type(4)));
typedef unsigned u32x4 __attribute__((ext_vector_type(4)));
constexpr int BM = 256, BK = 64, HALF = 128, HTB = HALF * BK * 2  , STAGE_BYTES = 8 * HTB, NXCD = 8, WGM = 8;

__host__ __device__ __forceinline__ int lds_byte(int r, int c) { const int st = (r >> 4) * 2 + (c >> 5), rr = r & 15, cc = c & 31, ob = rr * 64 + cc * 2; return st * 1024 + (ob ^ (((ob >> 9) & 1) << 5)); }
__host__ __device__ __forceinline__ void stage_rc(int b, int& R, int& C) { const int st = b / 1024, sb = b % 1024, swz = sb ^ (((sb >> 9) & 1) << 5); R = (st >> 1) * 16 + swz / 64; C = (st & 1) * 32 + (swz % 64) / 2; }
__host__ __device__ __forceinline__ int perm32(int rho) { const int n = rho >> 4, i = rho & 15; return 8 * (i >> 2) + 4 * n + (i & 3); }

struct Unit { int pm, pn; };
struct Gemm { const bf16_t* A; const bf16_t* Bt; int M, N, K; };

struct StaticOrder {
    int nM, nN, nwg, G, c;
    __host__ __device__ void init(int M, int N, int G_, int c_) { nM = M / BM; nN = N / BM; nwg = nM * nN; G = G_; c = c_; }
    __host__ __device__ bool next(int i, Unit& u) const {
        const long L = (long)i * G + c; if (L >= nwg) return false;
        int wgid = (int)L; { const int q = nwg / NXCD, r = nwg % NXCD, xcd = wgid % NXCD, off = wgid / NXCD; wgid = (xcd < r ? xcd * (q + 1) : r * (q + 1) + (xcd - r) * q) + off; }
        const int nig = WGM * nN, gid = wgid / nig, fm = gid * WGM, gsz = (nM - fm) < WGM ? (nM - fm) : WGM;
        u.pm = fm + ((wgid % nig) % gsz); u.pn = (wgid % nig) / gsz; return true;
    }
    __device__ __forceinline__ void a_ready(const Unit&) const {}
    __device__ __forceinline__ void done(const Unit&) const {}
};

__device__ __forceinline__ unsigned cvt_pk_bf16(float lo, float hi) { unsigned r; asm volatile("v_cvt_pk_bf16_f32 %0, %1, %2" : "=v"(r) : "v"(lo), "v"(hi)); return r; }
typedef float f32x2 __attribute__((ext_vector_type(2)));
__device__ __forceinline__ float sigm(float x) { return __builtin_amdgcn_rcpf(1.0f + __builtin_amdgcn_exp2f(-1.44269504f * x)); }
__device__ __forceinline__ float bflo(unsigned w) { return __uint_as_float(w << 16); }
__device__ __forceinline__ float bfhi(unsigned w) { return __uint_as_float(w & 0xffff0000u); }
constexpr float RMS_EPS = 1e-6f;

struct EpiSwiglu {
    static constexpr bool PERM = true, AFTER_DRAIN = false, MIDK = false, ROWSTAT = true;
    bf16_t* O; const float* ss;
    __device__ __forceinline__ void operator()(const f32x4 (&acc)[2][2][4][2], const Unit& u, int wr, int wc, int fr, int fq, const PG8_LAS float* rs, PG8_LAS float* xch, int tid) const {
        const int row0 = u.pm * BM + wr * 64 + fr, col0 = u.pn * 128 + wc * 32 + 8 * fq;
        float rv[2][4];
#pragma unroll
        for (int ai = 0; ai < 2; ++ai)
#pragma unroll
            for (int m = 0; m < 4; ++m) { const f32x4 q4 = *(const PG8_LAS f32x4*)(rs + (ai * HALF + wr * 64 + m * 16 + fr) * 4); rv[ai][m] = (q4[0] + q4[1]) + (q4[2] + q4[3]); }
#pragma unroll
        for (int ai = 0; ai < 2; ++ai)
#pragma unroll
            for (int m = 0; m < 4; ++m) {
                const int row = row0 + ai * HALF + m * 16;
                const float rinv = __builtin_amdgcn_rsqf(rv[ai][m] * (1.0f / 1024.0f) + RMS_EPS);
                const float nrl = -1.44269504f * rinv, rsq2 = rinv * rinv;
                unsigned ww[4];
#pragma unroll
                for (int n = 0; n < 2; ++n) {
                    const f32x4 ag = acc[ai][0][m][n], au = acc[ai][1][m][n];
                    const f32x4 t = ag * nrl;
                    f32x4 e; e[0] = __builtin_amdgcn_exp2f(t[0]); e[1] = __builtin_amdgcn_exp2f(t[1]); e[2] = __builtin_amdgcn_exp2f(t[2]); e[3] = __builtin_amdgcn_exp2f(t[3]);
                    const f32x4 d = e + 1.0f;
                    f32x4 r; r[0] = __builtin_amdgcn_rcpf(d[0]); r[1] = __builtin_amdgcn_rcpf(d[1]); r[2] = __builtin_amdgcn_rcpf(d[2]); r[3] = __builtin_amdgcn_rcpf(d[3]);
                    const f32x4 a = (ag * au) * (r * rsq2);
                    ww[2 * n] = cvt_pk_bf16(a[0], a[1]); ww[2 * n + 1] = cvt_pk_bf16(a[2], a[3]);
                }
                u32x4 w; w.x = ww[0]; w.y = ww[1]; w.z = ww[2]; w.w = ww[3];
                *(u32x4*)(O + (size_t)row * 2816 + col0) = w;
            }
    }
};

#define UNPK8(V_, lo4, hi4) do { const u32x4 v__ = (V_); lo4 = (f32x4){bflo(v__.x), bfhi(v__.x), bflo(v__.y), bfhi(v__.y)}; hi4 = (f32x4){bflo(v__.z), bfhi(v__.z), bflo(v__.w), bfhi(v__.w)}; } while (0)
#define SUMSQ8(a, b) (((a)[0] * (a)[0] + (a)[1] * (a)[1]) + ((a)[2] * (a)[2] + (a)[3] * (a)[3]) + ((b)[0] * (b)[0] + (b)[1] * (b)[1]) + ((b)[2] * (b)[2] + (b)[3] * (b)[3]))
template <bool BASE_F32> struct EpiRes {
    static constexpr bool PERM = true, AFTER_DRAIN = false, MIDK = false, ROWSTAT = false;
    const float* base; bf16_t* hb; float* ssout; float alpha;
    __device__ __forceinline__ void operator()(const f32x4 (&acc)[2][2][4][2], const Unit& u, int wr, int wc, int fr, int fq, const PG8_LAS float* rs, PG8_LAS float* xch, int tid) const {
        const int row0 = u.pm * BM + wr * 64 + fr, col0 = u.pn * BM + wc * 32 + 8 * fq;
        if constexpr (!BASE_F32) {
            u32x4 pw[2][4][2];
#pragma unroll
            for (int ai = 0; ai < 2; ++ai)
#pragma unroll
                for (int m = 0; m < 4; ++m)
#pragma unroll
                    for (int bj = 0; bj < 2; ++bj) pw[ai][m][bj] = *(const u32x4*)(hb + (size_t)(row0 + ai * HALF + m * 16) * 1024 + col0 + bj * HALF);
#pragma unroll
            for (int ai = 0; ai < 2; ++ai)
#pragma unroll
                for (int m = 0; m < 4; ++m) {
                    const int row = row0 + ai * HALF + m * 16; float s = 0.f;
#pragma unroll
                    for (int bj = 0; bj < 2; ++bj) {
                        const size_t off = (size_t)row * 1024 + col0 + bj * HALF;
                        f32x4 b0, b1; UNPK8(pw[ai][m][bj], b0, b1);
                        const f32x4 o0 = b0 + acc[ai][bj][m][0] * alpha, o1 = b1 + acc[ai][bj][m][1] * alpha;
                        u32x4 w; w.x = cvt_pk_bf16(o0[0], o0[1]); w.y = cvt_pk_bf16(o0[2], o0[3]); w.z = cvt_pk_bf16(o1[0], o1[1]); w.w = cvt_pk_bf16(o1[2], o1[3]);
                        *(u32x4*)(hb + off) = w;
                        s += SUMSQ8(o0, o1);
                    }
                    s += __shfl_xor(s, 16); s += __shfl_xor(s, 32);
                    if (fq == 0) xch[(row - u.pm * BM) * 4 + wc] = s;
                }
        } else {
            f32x4 pb[2][2][2][2];
#define ER_LOAD(slot, g) do { _Pragma("unroll") for (int mm = 0; mm < 2; ++mm) _Pragma("unroll") for (int bj = 0; bj < 2; ++bj) { \
                const size_t off_ = (size_t)(row0 + ((g) >> 1) * HALF + (2 * ((g) & 1) + mm) * 16) * 1024 + col0 + bj * HALF; \
                pb[slot][mm][bj][0] = __builtin_nontemporal_load((const f32x4*)(base + off_)); pb[slot][mm][bj][1] = __builtin_nontemporal_load((const f32x4*)(base + off_ + 4)); } } while (0)
            ER_LOAD(0, 0);
#pragma unroll
            for (int g = 0; g < 4; ++g) {
                if (g + 1 < 4) ER_LOAD((g + 1) & 1, g + 1);
#pragma unroll
                for (int mm = 0; mm < 2; ++mm) {
                    const int ai = g >> 1, m = 2 * (g & 1) + mm; const int row = row0 + ai * HALF + m * 16; float s = 0.f;
#pragma unroll
                    for (int bj = 0; bj < 2; ++bj) {
                        const size_t off = (size_t)row * 1024 + col0 + bj * HALF;
                        const f32x4 o0 = pb[g & 1][mm][bj][0] + acc[ai][bj][m][0] * alpha, o1 = pb[g & 1][mm][bj][1] + acc[ai][bj][m][1] * alpha;
                        u32x4 w; w.x = cvt_pk_bf16(o0[0], o0[1]); w.y = cvt_pk_bf16(o0[2], o0[3]); w.z = cvt_pk_bf16(o1[0], o1[1]); w.w = cvt_pk_bf16(o1[2], o1[3]);
                        *(u32x4*)(hb + off) = w;
                        s += SUMSQ8(o0, o1);
                    }
                    s += __shfl_xor(s, 16); s += __shfl_xor(s, 32);
                    if (fq == 0) xch[(row - u.pm * BM) * 4 + wc] = s;
                }
            }
#undef ER_LOAD
        }
        asm volatile("s_waitcnt lgkmcnt(0)\n\ts_barrier" ::: "memory");
        if (tid < BM) { const f32x4 q4 = *(const PG8_LAS f32x4*)(xch + tid * 4); ssout[((size_t)u.pm * BM + tid) * 4 + u.pn] = (q4[0] + q4[1]) + (q4[2] + q4[3]); }
    }
};

struct EpiWin {
    static constexpr bool PERM = true, AFTER_DRAIN = false, MIDK = false, ROWSTAT = true;
    const float* ss; const float* lbp; bf16_t *Q, *Kb, *VT, *RQ, *RG, *RIT, *SG, *GA, *GB;
    __device__ __forceinline__ void operator()(const f32x4 (&acc)[2][2][4][2], const Unit& u, int wr, int wc, int fr, int fq, const PG8_LAS float* rs, PG8_LAS float* xch, int tid) const {
        const int pn = u.pn, row0 = u.pm * BM + wr * 64 + fr, cl = wc * 32 + 8 * fq;
        int kind = 0; float scale = 1.f; bf16_t* dst = Q; int pitch = 512, cbase = 0; int trw = 0;
        if (pn < 2) { dst = Q; cbase = pn * 256; scale = 0.125f; }
        else if (pn == 2) { dst = Kb; pitch = 128; cbase = 0; }
        else if (pn < 5) { dst = RQ; cbase = (pn - 3) * 256; }
        else if (pn < 7) { dst = RG; cbase = (pn - 5) * 256; kind = 1; }
        else if (pn < 9) { dst = RIT; cbase = (pn - 7) * 256; trw = 512; }
        else if (pn < 11) { dst = SG; cbase = (pn - 9) * 256; kind = 2; }
        else { dst = GA; pitch = 1024; cbase = (pn - 11) * 128; kind = 3; }
        f32x4 lb[2][2];
#pragma unroll
        for (int bj = 0; bj < 2; ++bj)
#pragma unroll
            for (int n = 0; n < 2; ++n) lb[bj][n] = (f32x4){0.f, 0.f, 0.f, 0.f};
        if (kind == 1) {
#pragma unroll
            for (int bj = 0; bj < 2; ++bj)
#pragma unroll
                for (int n = 0; n < 2; ++n) {
                    const int c = cbase + bj * HALF + cl + 4 * n;
                    const f32x4 p0 = *(const f32x4*)(lbp + c), p1 = *(const f32x4*)(lbp + 512 + c);
#pragma unroll
                    for (int j = 0; j < 4; ++j) lb[bj][n][j] = sigm(p0[j] - p1[j]);
                }
        }
        float rv[2][4];
#pragma unroll
        for (int ai = 0; ai < 2; ++ai)
#pragma unroll
            for (int m = 0; m < 4; ++m) { const f32x4 q4 = *(const PG8_LAS f32x4*)(rs + (ai * HALF + wr * 64 + m * 16 + fr) * 4); rv[ai][m] = (q4[0] + q4[1]) + (q4[2] + q4[3]); }
        if (kind == 3) {
#pragma unroll
            for (int ai = 0; ai < 2; ++ai)
#pragma unroll
                for (int m = 0; m < 4; ++m) {
                    const int row = row0 + ai * HALF + m * 16;
                    const float nrl = -1.44269504f * __builtin_amdgcn_rsqf(rv[ai][m] * (1.0f / 1024.0f) + RMS_EPS);
                    f32x4 rt[2], sb[2];
#pragma unroll
                    for (int n = 0; n < 2; ++n) {
                        const f32x4 ta = acc[ai][0][m][n] * nrl, tb = acc[ai][1][m][n] * nrl;
#pragma unroll
                        for (int j = 0; j < 4; ++j) { const float da = 1.0f + __builtin_amdgcn_exp2f(ta[j]), db = 1.0f + __builtin_amdgcn_exp2f(tb[j]); const float rb = __builtin_amdgcn_rcpf(db);
                            sb[n][j] = rb; rt[n][j] = fminf(db * __builtin_amdgcn_rcpf(da), 3.0e38f); }
                    }
                    u32x4 w; w.x = cvt_pk_bf16(rt[0][0], rt[0][1]); w.y = cvt_pk_bf16(rt[0][2], rt[0][3]); w.z = cvt_pk_bf16(rt[1][0], rt[1][1]); w.w = cvt_pk_bf16(rt[1][2], rt[1][3]);
                    *(u32x4*)(GA + (size_t)row * 1024 + cbase + cl) = w;
                    w.x = cvt_pk_bf16(sb[0][0], sb[0][1]); w.y = cvt_pk_bf16(sb[0][2], sb[0][3]); w.z = cvt_pk_bf16(sb[1][0], sb[1][1]); w.w = cvt_pk_bf16(sb[1][2], sb[1][3]);
                    *(u32x4*)(GB + (size_t)row * 1024 + cbase + cl) = w;
                }
            return;
        }
#pragma unroll
        for (int ai = 0; ai < 2; ++ai)
#pragma unroll
            for (int m = 0; m < 4; ++m) {
                const int row = row0 + ai * HALF + m * 16;
                const float rinv = __builtin_amdgcn_rsqf(rv[ai][m] * (1.0f / 1024.0f) + RMS_EPS);
#pragma unroll
                for (int bj = 0; bj < 2; ++bj) {
                    f32x4 v[2];
#pragma unroll
                    for (int n = 0; n < 2; ++n) {
                        v[n] = acc[ai][bj][m][n] * rinv;
                        if (kind == 0) v[n] = v[n] * scale;
                        else {
#pragma unroll
                            for (int j = 0; j < 4; ++j) v[n][j] = sigm(v[n][j]);
                            if (kind == 1) {
#pragma unroll
                                for (int j = 0; j < 4; ++j) v[n][j] = __builtin_amdgcn_logf(lb[bj][n][j] + (1.0f - lb[bj][n][j]) * v[n][j]) * 0.69314718056f;
                            }
                        }
                    }
                    const bool tr = (trw != 0) || (pn == 2 && bj == 1);
                    if (!tr) {
                        u32x4 w; w.x = cvt_pk_bf16(v[0][0], v[0][1]); w.y = cvt_pk_bf16(v[0][2], v[0][3]); w.z = cvt_pk_bf16(v[1][0], v[1][1]); w.w = cvt_pk_bf16(v[1][2], v[1][3]);
                        *(u32x4*)(dst + (size_t)row * pitch + cbase + bj * HALF + cl) = w;
                    } else {
                        bf16_t* tb = (pn == 2) ? VT : RIT; const int cw = (pn == 2) ? 128 : 512; const int c0 = (pn == 2) ? cl : cbase + bj * HALF + cl;
                        bf16_t* p = tb + (((size_t)((row >> 11) * cw + c0)) << 11) + (row & 2047);
#pragma unroll
                        for (int n = 0; n < 2; ++n)
#pragma unroll
                            for (int j = 0; j < 4; ++j) p[(size_t)(4 * n + j) << 11] = (bf16_t)(cvt_pk_bf16(v[n][j], v[n][j]) & 0xffffu);
                    }
                }
            }
    }
};

template <bool ADD> struct EpiGate {
    static constexpr bool PERM = true, AFTER_DRAIN = false, MIDK = false, ROWSTAT = false;
    const bf16_t* gate; bf16_t* MG;
    __device__ __forceinline__ void operator()(const f32x4 (&acc)[2][2][4][2], const Unit& u, int wr, int wc, int fr, int fq, const PG8_LAS float* rs, PG8_LAS float* xch, int tid) const {
        const int row0 = u.pm * BM + wr * 64 + fr, col0 = u.pn * BM + wc * 32 + 8 * fq;
        u32x4 gwb[2][2][2], pwb[2][2][2];
#define EG_LOAD(slot, g) do { _Pragma("unroll") for (int mm = 0; mm < 2; ++mm) _Pragma("unroll") for (int bj = 0; bj < 2; ++bj) { \
            const size_t off_ = (size_t)(row0 + ((g) >> 1) * HALF + (2 * ((g) & 1) + mm) * 16) * 1024 + col0 + bj * HALF; \
            gwb[slot][mm][bj] = *(const u32x4*)(gate + off_); if (ADD) pwb[slot][mm][bj] = *(const u32x4*)(MG + off_); } } while (0)
        EG_LOAD(0, 0);
#pragma unroll
        for (int g = 0; g < 4; ++g) {
            if (g + 1 < 4) EG_LOAD((g + 1) & 1, g + 1);
#pragma unroll
            for (int mm = 0; mm < 2; ++mm) {
                const int ai = g >> 1, m = 2 * (g & 1) + mm; const int row = row0 + ai * HALF + m * 16;
#pragma unroll
                for (int bj = 0; bj < 2; ++bj) {
                    const size_t off = (size_t)row * 1024 + col0 + bj * HALF;
                    f32x4 g0, g1; UNPK8(gwb[g & 1][mm][bj], g0, g1);
                    f32x4 o0 = g0 * acc[ai][bj][m][0], o1 = g1 * acc[ai][bj][m][1];
                    if (ADD) { f32x4 p0, p1; UNPK8(pwb[g & 1][mm][bj], p0, p1); o0 += p0; o1 += p1; }
                    u32x4 w; w.x = cvt_pk_bf16(o0[0], o0[1]); w.y = cvt_pk_bf16(o0[2], o0[3]); w.z = cvt_pk_bf16(o1[0], o1[1]); w.w = cvt_pk_bf16(o1[2], o1[3]);
                    *(u32x4*)(MG + off) = w;
                }
            }
        }
#undef EG_LOAD
    }
};

struct EpiStoreBf16 {
    static constexpr bool PERM = true, AFTER_DRAIN = false, MIDK = false, ROWSTAT = false;
    bf16_t* T;
    __device__ __forceinline__ void operator()(const f32x4 (&acc)[2][2][4][2], const Unit& u, int wr, int wc, int fr, int fq, const PG8_LAS float* rs, PG8_LAS float* xch, int tid) const {
        const int row0 = u.pm * BM + wr * 64 + fr, col0 = u.pn * BM + wc * 32 + 8 * fq;
#pragma unroll
        for (int ai = 0; ai < 2; ++ai)
#pragma unroll
            for (int m = 0; m < 4; ++m) {
                const int row = row0 + ai * HALF + m * 16;
#pragma unroll
                for (int bj = 0; bj < 2; ++bj) {
                    const size_t off = (size_t)row * 1024 + col0 + bj * HALF;
                    const f32x4 a0 = acc[ai][bj][m][0], a1 = acc[ai][bj][m][1];
                    u32x4 w; w.x = cvt_pk_bf16(a0[0], a0[1]); w.y = cvt_pk_bf16(a0[2], a0[3]); w.z = cvt_pk_bf16(a1[0], a1[1]); w.w = cvt_pk_bf16(a1[2], a1[3]);
                    *(u32x4*)(T + off) = w;
                }
            }
    }
};

struct EpiPle2 {
    static constexpr bool PERM = true, AFTER_DRAIN = false, MIDK = false, ROWSTAT = true;
    const float* ss; const bf16_t* T; const bf16_t* h3b; bf16_t* h4b; float* ssout;
    __device__ __forceinline__ void operator()(const f32x4 (&acc)[2][2][4][2], const Unit& u, int wr, int wc, int fr, int fq, const PG8_LAS float* rs, PG8_LAS float* xch, int tid) const {
        const int row0 = u.pm * BM + wr * 64 + fr, col0 = u.pn * BM + wc * 32 + 8 * fq;
        float rv[2][4];
#pragma unroll
        for (int ai = 0; ai < 2; ++ai)
#pragma unroll
            for (int m = 0; m < 4; ++m) { const f32x4 q4 = *(const PG8_LAS f32x4*)(rs + (ai * HALF + wr * 64 + m * 16 + fr) * 4); rv[ai][m] = (q4[0] + q4[1]) + (q4[2] + q4[3]); }
        u32x4 hwb[2][2], twb[2][2];
#define EP_LOAD(slot, g) do { _Pragma("unroll") for (int bj = 0; bj < 2; ++bj) { \
            const size_t off_ = (size_t)(row0 + ((g) >> 2) * HALF + ((g) & 3) * 16) * 1024 + col0 + bj * HALF; \
            hwb[slot][bj] = *(const u32x4*)(h3b + off_); twb[slot][bj] = *(const u32x4*)(T + off_); } } while (0)
        EP_LOAD(0, 0);
#pragma unroll
        for (int g = 0; g < 8; ++g) {
            if (g + 1 < 8) EP_LOAD((g + 1) & 1, g + 1);
            {
                const int ai = g >> 2, m = g & 3; const int row = row0 + ai * HALF + m * 16; float s = 0.f;
                const float rinv = __builtin_amdgcn_rsqf(rv[ai][m] * (1.0f / 1024.0f) + RMS_EPS);
#pragma unroll
                for (int bj = 0; bj < 2; ++bj) {
                    const size_t off = (size_t)row * 1024 + col0 + bj * HALF;
                    f32x4 b0, b1, t0, t1; UNPK8(hwb[g & 1][bj], b0, b1); UNPK8(twb[g & 1][bj], t0, t1);
                    f32x4 o0, o1;
#pragma unroll
                    for (int j = 0; j < 4; ++j) { o0[j] = b0[j] + sigm(acc[ai][bj][m][0][j] * rinv) * t0[j]; o1[j] = b1[j] + sigm(acc[ai][bj][m][1][j] * rinv) * t1[j]; }
                    u32x4 w; w.x = cvt_pk_bf16(o0[0], o0[1]); w.y = cvt_pk_bf16(o0[2], o0[3]); w.z = cvt_pk_bf16(o1[0], o1[1]); w.w = cvt_pk_bf16(o1[2], o1[3]);
                    *(u32x4*)(h4b + off) = w;
                    s += SUMSQ8(o0, o1);
                }
                s += __shfl_xor(s, 16); s += __shfl_xor(s, 32);
                if (fq == 0) xch[(row - u.pm * BM) * 4 + wc] = s;
            }
        }
#undef EP_LOAD
        asm volatile("s_waitcnt lgkmcnt(0)\n\ts_barrier" ::: "memory");
        if (tid < BM) { const f32x4 q4 = *(const PG8_LAS f32x4*)(xch + tid * 4); ssout[((size_t)u.pm * BM + tid) * 4 + u.pn] = (q4[0] + q4[1]) + (q4[2] + q4[3]); }
    }
};


struct EpiMerge {
    static constexpr bool PERM = true, AFTER_DRAIN = false, MIDK = true, ROWSTAT = false;
    const bf16_t* RT; const bf16_t* SB; bf16_t* MG;
    __device__ __forceinline__ void mid(f32x4 (&acc)[2][2][4][2], const Unit& u, int wr, int wc, int fr, int fq) const {
        const int row0 = u.pm * BM + wr * 64 + fr, col0 = u.pn * BM + wc * 32 + 8 * fq;
#pragma unroll
        for (int ai = 0; ai < 2; ++ai) {
            u32x4 gw[4][2];
#pragma unroll
            for (int m = 0; m < 4; ++m)
#pragma unroll
                for (int bj = 0; bj < 2; ++bj) gw[m][bj] = *(const u32x4*)(RT + (size_t)(row0 + ai * HALF + m * 16) * 1024 + col0 + bj * HALF);
#pragma unroll
            for (int m = 0; m < 4; ++m)
#pragma unroll
                for (int bj = 0; bj < 2; ++bj) { f32x4 g0, g1; UNPK8(gw[m][bj], g0, g1); acc[ai][bj][m][0] = acc[ai][bj][m][0] * g0; acc[ai][bj][m][1] = acc[ai][bj][m][1] * g1; }
        }
    }
    __device__ __forceinline__ void operator()(const f32x4 (&acc)[2][2][4][2], const Unit& u, int wr, int wc, int fr, int fq, const PG8_LAS float* rs, PG8_LAS float* xch, int tid) const {
        const int row0 = u.pm * BM + wr * 64 + fr, col0 = u.pn * BM + wc * 32 + 8 * fq;
        u32x4 gw[2][4][2];
#pragma unroll
        for (int ai = 0; ai < 2; ++ai)
#pragma unroll
            for (int m = 0; m < 4; ++m)
#pragma unroll
                for (int bj = 0; bj < 2; ++bj) gw[ai][m][bj] = *(const u32x4*)(SB + (size_t)(row0 + ai * HALF + m * 16) * 1024 + col0 + bj * HALF);
#pragma unroll
        for (int ai = 0; ai < 2; ++ai)
#pragma unroll
            for (int m = 0; m < 4; ++m)
#pragma unroll
                for (int bj = 0; bj < 2; ++bj) {
                    f32x4 g0, g1; UNPK8(gw[ai][m][bj], g0, g1);
                    const f32x4 o0 = g0 * acc[ai][bj][m][0], o1 = g1 * acc[ai][bj][m][1];
                    u32x4 w; w.x = cvt_pk_bf16(o0[0], o0[1]); w.y = cvt_pk_bf16(o0[2], o0[3]); w.z = cvt_pk_bf16(o1[0], o1[1]); w.w = cvt_pk_bf16(o1[2], o1[3]);
                    *(u32x4*)(MG + (size_t)(row0 + ai * HALF + m * 16) * 1024 + col0 + bj * HALF) = w;
                }
    }
};

template <class Epi, class Sched, bool ALIGN_EPI = false, bool SP2 = false>
__device__ __forceinline__ void gemm_phase(PG8_LAS unsigned char* lds, const Gemm g, const Sched& S, const Epi& E) {
    int tid_ = threadIdx.x; asm volatile("" : "+v"(tid_));
    const int tid = tid_, wid = __builtin_amdgcn_readfirstlane(tid >> 6), lane = tid & 63, wr = wid >> 2, wc = wid & 3, fr = lane & 15, fq = lane >> 4;
    const int K = g.K, nt = K / BK;
    unsigned voffA[2], voffB[2];
#pragma unroll
    for (int i = 0; i < 2; ++i) { int R, C; stage_rc(tid * 16 + i * 8192, R, C); const int Rb = Epi::PERM ? ((R & ~31) + perm32(R & 31)) : R;
        voffA[i] = (unsigned)(R * K + C) * 2u; voffB[i] = (unsigned)(Rb * K + C) * 2u; }
    const size_t kstep = (size_t)(BK * 2);
    const size_t hstep = (size_t)HALF * K * 2;
    const size_t tstep = 2 * hstep;
    const unsigned ldsw = (unsigned)wid * 1024u;
    const int aoff = lds_byte(wr * 64 + fr, fq * 8), boff = lds_byte(wc * 32 + fr, fq * 8);
#define PG8_SA(b, h) (((b) * 2 + (h)) * HTB)
#define PG8_SB(b, h) ((4 + (b) * 2 + (h)) * HTB)
#define PG8_STAGE(bufoff, gbase, voff) do { _Pragma("unroll") for (int _i = 0; _i < 2; ++_i) \
        __builtin_amdgcn_global_load_lds((const unsigned*)((const char*)(gbase) + (voff)[_i]), (PG8_LAS unsigned*)(lds + (bufoff) + ldsw + _i * 8192), 16, 0, 0); } while (0)
#define PG8_LDA(dst, b, h) do { _Pragma("unroll") for (int m = 0; m < 4; ++m) _Pragma("unroll") for (int k = 0; k < 2; ++k) dst[m][k] = *(const PG8_LAS bf16x8*)(lds + PG8_SA(b, h) + aoff + m * 2048 + k * 1024); } while (0)
#define PG8_LDB(dst, b, h) do { _Pragma("unroll") for (int n = 0; n < 2; ++n) _Pragma("unroll") for (int k = 0; k < 2; ++k) dst[n][k] = *(const PG8_LAS bf16x8*)(lds + PG8_SB(b, h) + boff + n * 2048 + k * 1024); } while (0)
#define PG8_MMA(ai, bj, At, Bt) do { __builtin_amdgcn_s_setprio(1); _Pragma("unroll") for (int m = 0; m < 4; ++m) _Pragma("unroll") for (int n = 0; n < 2; ++n) _Pragma("unroll") for (int k = 0; k < 2; ++k) \
        acc[ai][bj][m][n] = __builtin_amdgcn_mfma_f32_16x16x32_bf16(Bt[n][k], At[m][k], acc[ai][bj][m][n], 0, 0, 0); __builtin_amdgcn_s_setprio(0); } while (0)
#define PG8_WAIT_V(n) asm volatile("s_waitcnt vmcnt(" #n ")" ::: "memory")
#define PG8_WAIT_L(n) asm volatile("s_waitcnt lgkmcnt(" #n ")" ::: "memory")
#define PG8_BAR __builtin_amdgcn_s_barrier()
#define PG8_SCHED __builtin_amdgcn_sched_barrier(0)
    Unit cur, nxt; int ui = 0;
    if (!S.next(0, cur)) return;
#define PG8_ROWSTAT_DMA(unit_, ui_) do { if constexpr (Epi::ROWSTAT) { if (wid < 4) { unsigned keep_; const float* gp_ = E.ss + ((size_t)(unit_).pm * BM + wid * 64 + lane) * 4; \
        const unsigned dst_ = (unsigned)__builtin_amdgcn_readfirstlane((int)((unsigned)(size_t)lds + 133120u + (unsigned)((ui_) & 1) * 4096u + (unsigned)wid * 1024u)); \
        asm volatile("s_mov_b32 %0, m0\n\ts_mov_b32 m0, %2\n\ts_nop 0\n\tglobal_load_lds_dwordx4 %1, off\n\ts_mov_b32 m0, %0" : "=&s"(keep_) : "v"(gp_), "s"(dst_) : "memory"); } } } while (0)
    PG8_ROWSTAT_DMA(cur, 0);
    f32x4 acc[2][2][4][2];
#pragma unroll
    for (int a = 0; a < 2; ++a)
#pragma unroll
        for (int b = 0; b < 2; ++b)
#pragma unroll
            for (int m = 0; m < 4; ++m)
#pragma unroll
                for (int n = 0; n < 2; ++n) acc[a][b][m][n] = (f32x4){0.f, 0.f, 0.f, 0.f};
    bf16x8 At[4][2], B0[2][2], B1[2][2];
    const char* cA = (const char*)g.A + (size_t)cur.pm * tstep; const char* cB = (const char*)g.Bt + (size_t)cur.pn * tstep;
    S.a_ready(cur);
    if constexpr (SP2) {
        PG8_STAGE(PG8_SB(0, 0), cB, voffB); PG8_STAGE(PG8_SB(0, 1), cB + hstep, voffB); PG8_STAGE(PG8_SA(0, 0), cA, voffA); PG8_STAGE(PG8_SA(0, 1), cA + hstep, voffA);
        if (wr == 1) PG8_BAR;
        PG8_WAIT_V(2); PG8_BAR;
        PG8_STAGE(PG8_SB(1, 0), cB + kstep, voffB); PG8_STAGE(PG8_SA(1, 0), cA + kstep, voffA); PG8_STAGE(PG8_SB(1, 1), cB + hstep + kstep, voffB);
        PG8_WAIT_V(6); PG8_BAR;
    } else {
        PG8_STAGE(PG8_SB(0, 0), cB, voffB); PG8_STAGE(PG8_SA(0, 0), cA, voffA); PG8_STAGE(PG8_SB(0, 1), cB + hstep, voffB); PG8_STAGE(PG8_SA(0, 1), cA + hstep, voffA);
        if (wr == 1) PG8_BAR;
        PG8_WAIT_V(4); PG8_BAR;
        PG8_STAGE(PG8_SB(1, 0), cB + kstep, voffB); PG8_STAGE(PG8_SA(1, 0), cA + kstep, voffA); PG8_STAGE(PG8_SB(1, 1), cB + hstep + kstep, voffB);
        PG8_WAIT_V(6); PG8_BAR;
    }
    for (;;) {
        const bool has_next = S.next(ui + 1, nxt);
        const char* nA = has_next ? (const char*)g.A + (size_t)nxt.pm * tstep : cA; const char* nB = has_next ? (const char*)g.Bt + (size_t)nxt.pn * tstep : cB;
        for (int t = 0; t < nt; t += 2) {
            const bool last = (t == nt - 2);
            if constexpr (Epi::MIDK) { if (t == nt / 2) { int t3_ = threadIdx.x; asm volatile("" : "+v"(t3_)); const int l3_ = t3_ & 63, w3_ = __builtin_amdgcn_readfirstlane(t3_ >> 6);
                E.mid(acc, cur, w3_ >> 2, w3_ & 3, l3_ & 15, l3_ >> 4); } }
            const char* a1 = cA + (size_t)(t + 1) * kstep;
            const char* a2 = last ? nA : cA + (size_t)(t + 2) * kstep; const char* b2 = last ? nB : cB + (size_t)(t + 2) * kstep;
            const char* a3 = a2 + kstep; const char* b3 = b2 + kstep;
            if (last && has_next) S.a_ready(nxt);
            if constexpr (SP2) {
            PG8_LDB(B0, 0, 0); PG8_LDB(B1, 0, 1); PG8_SCHED; PG8_LDA(At, 0, 0); PG8_STAGE(PG8_SA(1, 1), a1 + hstep, voffA);
            PG8_WAIT_V(8); PG8_WAIT_L(0); PG8_BAR; PG8_MMA(0, 0, At, B0); PG8_MMA(0, 1, At, B1); PG8_BAR; PG8_SCHED;
            PG8_LDA(At, 0, 1); PG8_STAGE(PG8_SB(0, 0), b2, voffB); PG8_STAGE(PG8_SB(0, 1), b2 + hstep, voffB); PG8_STAGE(PG8_SA(0, 0), a2, voffA);
            PG8_WAIT_V(8); PG8_WAIT_L(0); PG8_BAR; PG8_MMA(1, 0, At, B0); PG8_MMA(1, 1, At, B1); PG8_BAR; PG8_SCHED;
            PG8_LDB(B0, 1, 0); PG8_LDB(B1, 1, 1); PG8_SCHED; PG8_LDA(At, 1, 0); PG8_STAGE(PG8_SA(0, 1), a2 + hstep, voffA);
            PG8_WAIT_V(8); PG8_WAIT_L(0); PG8_BAR; PG8_MMA(0, 0, At, B0); PG8_MMA(0, 1, At, B1); PG8_BAR; PG8_SCHED;
            PG8_LDA(At, 1, 1); PG8_STAGE(PG8_SB(1, 0), b3, voffB); PG8_STAGE(PG8_SB(1, 1), b3 + hstep, voffB); PG8_STAGE(PG8_SA(1, 0), a3, voffA);
            PG8_WAIT_V(8); PG8_WAIT_L(0); PG8_BAR; PG8_MMA(1, 0, At, B0); PG8_MMA(1, 1, At, B1); PG8_BAR; PG8_SCHED;
            } else {
            PG8_LDB(B0, 0, 0); PG8_SCHED; PG8_LDA(At, 0, 0); PG8_STAGE(PG8_SA(1, 1), a1 + hstep, voffA);
            PG8_WAIT_L(8); PG8_BAR; PG8_WAIT_L(0); PG8_MMA(0, 0, At, B0); PG8_BAR; PG8_SCHED;
            PG8_LDB(B1, 0, 1); PG8_STAGE(PG8_SB(0, 0), b2, voffB);
            PG8_BAR; PG8_WAIT_L(0); PG8_MMA(0, 1, At, B1); PG8_BAR;
            PG8_LDA(At, 0, 1); PG8_STAGE(PG8_SA(0, 0), a2, voffA);
            PG8_BAR; PG8_WAIT_L(0); PG8_MMA(1, 0, At, B0); PG8_BAR; PG8_SCHED;
            PG8_STAGE(PG8_SB(0, 1), b2 + hstep, voffB);
            PG8_WAIT_V(6); PG8_BAR; PG8_MMA(1, 1, At, B1); PG8_BAR;
            PG8_LDB(B0, 1, 0); PG8_SCHED; PG8_LDA(At, 1, 0); PG8_STAGE(PG8_SA(0, 1), a2 + hstep, voffA);
            PG8_WAIT_L(8); PG8_BAR; PG8_WAIT_L(0); PG8_MMA(0, 0, At, B0); PG8_BAR; PG8_SCHED;
            PG8_LDB(B1, 1, 1); PG8_STAGE(PG8_SB(1, 0), b3, voffB);
            PG8_BAR; PG8_WAIT_L(0); PG8_MMA(0, 1, At, B1); PG8_BAR;
            PG8_LDA(At, 1, 1); PG8_STAGE(PG8_SA(1, 0), a3, voffA);
            PG8_BAR; PG8_WAIT_L(0); PG8_MMA(1, 0, At, B0); PG8_BAR; PG8_SCHED;
            PG8_STAGE(PG8_SB(1, 1), b3 + hstep, voffB);
            PG8_WAIT_V(6); PG8_BAR; PG8_MMA(1, 1, At, B1); PG8_BAR;
            }
        }
        if constexpr (ALIGN_EPI) { if (wr == 0) PG8_BAR; }
        if constexpr (!Epi::AFTER_DRAIN) { int t2_ = threadIdx.x; asm volatile("" : "+v"(t2_)); const int l2_ = t2_ & 63, w2_ = __builtin_amdgcn_readfirstlane(t2_ >> 6);
            E(acc, cur, w2_ >> 2, w2_ & 3, l2_ & 15, l2_ >> 4, (const PG8_LAS float*)(lds + 133120 + (ui & 1) * 4096), (PG8_LAS float*)(lds + 141312), t2_); S.done(cur); }
        if (!has_next) break;
#pragma unroll
        for (int a = 0; a < 2; ++a)
#pragma unroll
            for (int b = 0; b < 2; ++b)
#pragma unroll
                for (int m = 0; m < 4; ++m)
#pragma unroll
                    for (int n = 0; n < 2; ++n) acc[a][b][m][n] = (f32x4){0.f, 0.f, 0.f, 0.f};
        cur = nxt; cA = nA; cB = nB; ++ui;
        if constexpr (ALIGN_EPI) { if (wr == 1) PG8_BAR; }
        PG8_ROWSTAT_DMA(cur, ui);
    }
    PG8_WAIT_V(0);
    if constexpr (!ALIGN_EPI) { if (wr == 0) PG8_BAR; }
    PG8_BAR;
    if constexpr (Epi::AFTER_DRAIN) { E.fused(acc, cur, wr, wc, fr, fq, lds, wid, lane); S.done(cur); }
#undef PG8_SA
#undef PG8_SB
#undef PG8_STAGE
#undef PG8_LDA
#undef PG8_LDB
#undef PG8_MMA
#undef PG8_WAIT_V
#undef PG8_WAIT_L
#undef PG8_BAR
#undef PG8_SCHED
#undef PG8_ROWSTAT_DMA
}
}

constexpr int MTOK = 65536, DM = 1024, DFF = 2816, SEQL = 2048, NBATCH = 32, INW = 4864, PLE = 256;
constexpr int STAGGER_US = 2;
constexpr int LDS_BYTES = 147456;
#define LAS __attribute__((address_space(3)))
typedef unsigned short bf16_t;
typedef float f32x4 __attribute__((ext_vector_type(4)));
typedef unsigned u32x4 __attribute__((ext_vector_type(4)));
typedef unsigned u32x2 __attribute__((ext_vector_type(2)));

constexpr size_t MiB = 1u << 20;
constexpr size_t WS_SS = 948 * MiB;
constexpr size_t WS_BAR = 1536 * 1024;
constexpr int MISC_OFF = 132096;
constexpr size_t WS_W1IN = 2 * MiB;
constexpr size_t WS_W1OUT = WS_W1IN + (size_t)5632 * 1024 * 2;
constexpr size_t WS_WIN = WS_W1OUT + (size_t)1024 * 2816 * 2;
constexpr size_t WS_WATT = WS_WIN + (size_t)4864 * 1024 * 2;
constexpr size_t WS_WREC = WS_WATT + (size_t)1024 * 512 * 2;
constexpr size_t WS_WOUT = WS_WREC + (size_t)1024 * 512 * 2;
constexpr size_t WS_W2IN = WS_WOUT + (size_t)1024 * 1024 * 2;
constexpr size_t WS_W2OUT = WS_W2IN + (size_t)5632 * 1024 * 2;
constexpr size_t WS_WG = WS_W2OUT + (size_t)1024 * 2816 * 2;
constexpr size_t WS_WP = WS_WG + (size_t)1024 * 1024 * 2;
constexpr size_t WS_WEND = WS_WP + (size_t)1024 * 256 * 2;
static_assert(WS_WEND <= 52 * MiB, "weights");
constexpr size_t WS_HB = 52 * MiB;
constexpr size_t WS_PB = WS_HB + 128 * MiB;
constexpr size_t WS_ATT = WS_PB + 32 * MiB;
constexpr size_t WS_REC = WS_ATT + 64 * MiB;
constexpr size_t WS_A = WS_REC + 64 * MiB;
constexpr size_t WS_Q = WS_A;
constexpr size_t WS_K = WS_Q + 64 * MiB;
constexpr size_t WS_VT = WS_K + 16 * MiB;
constexpr size_t WS_RQ = WS_VT + 16 * MiB;
constexpr size_t WS_RG = WS_RQ + 64 * MiB;
constexpr size_t WS_RIT = WS_RG + 64 * MiB;
constexpr size_t WS_SG = WS_RIT + 64 * MiB;
constexpr size_t WS_GA = WS_SG + 64 * MiB;
constexpr size_t WS_GB = WS_GA + 128 * MiB;
constexpr size_t WS_END = WS_GB + 128 * MiB;
constexpr size_t WS_ACT = WS_A;
constexpr size_t WS_MG = WS_A;
constexpr size_t WS_T = WS_A;
static_assert(WS_END <= 948 * MiB && WS_SS + (size_t)5 * MTOK * 16 <= 1024 * MiB, "d_ws map");

__device__ __forceinline__ float bf2f(unsigned short b) { return __uint_as_float((unsigned)b << 16); }
__device__ __forceinline__ float bflo(unsigned w) { return __uint_as_float(w << 16); }
__device__ __forceinline__ float bfhi(unsigned w) { return __uint_as_float(w & 0xffff0000u); }
__device__ __forceinline__ unsigned pk2(float lo, float hi) { return pg8::cvt_pk_bf16(lo, hi); }
#define LDS_WAIT() asm volatile("s_waitcnt lgkmcnt(0)" ::: "memory")

__constant__ unsigned char T5_BUCKET[128] = {0, 1, 2, 3, 4, 5, 6, 7, 8, 9, 10, 11, 12, 13, 14, 15, 16, 16, 16, 17, 17, 18, 18, 18, 19, 19, 19, 20, 20, 20, 20, 21, 21, 21, 21, 22, 22, 22, 22, 22, 23, 23, 23, 23, 23, 23, 24, 24, 24, 24, 24, 24, 25, 25, 25, 25, 25, 25, 25, 26, 26, 26, 26, 26, 26, 26, 26, 27, 27, 27, 27, 27, 27, 27, 27, 27, 27, 28, 28, 28, 28, 28, 28, 28, 28, 28, 28, 29, 29, 29, 29, 29, 29, 29, 29, 29, 29, 29, 29, 30, 30, 30, 30, 30, 30, 30, 30, 30, 30, 30, 30, 30, 30, 31, 31, 31, 31, 31, 31, 31, 31, 31, 31, 31, 31, 31, 31, 31};

__device__ __forceinline__ void p0_transpose_item(const float* W, int K, int N, bf16_t* WT, const float* gain, int swz, LAS float* scr, int item, int lane, int ldk = 0, int koff = 0) {
    if (ldk == 0) ldk = K;
    const int nblk = N / 32, kb = item / nblk, nb = item % nblk, k0 = 64 * kb, n0 = 32 * nb;
    int drow0 = n0;
    if (swz == 1) { const int up = n0 >= DFF ? 1 : 0; const int j = n0 - up * DFF; drow0 = 256 * (j >> 7) + (j & 127) + 128 * up; }
    if (swz == 2 && n0 >= 2816) { const int up = n0 >= 3840 ? 1 : 0; const int j = n0 - 2816 - up * 1024; drow0 = 2816 + 256 * (j >> 7) + (j & 127) + 128 * up; }
#pragma unroll
    for (int i = 0; i < 32; ++i) { const int kk = 2 * i + (lane >> 5); const float g = gain ? gain[k0 + kk] : 1.0f; scr[kk * 33 + (lane & 31)] = __builtin_nontemporal_load(W + (size_t)(k0 + kk) * N + n0 + (lane & 31)) * g; }
    LDS_WAIT(); asm volatile("" ::: "memory");
    const int c = lane & 7;
#pragma unroll
    for (int j = 0; j < 4; ++j) { const int n = (lane >> 3) + 8 * j; const LAS float* s = scr + (8 * c) * 33 + n;
        u32x4 o; o.x = pk2(s[0 * 33], s[1 * 33]); o.y = pk2(s[2 * 33], s[3 * 33]); o.z = pk2(s[4 * 33], s[5 * 33]); o.w = pk2(s[6 * 33], s[7 * 33]);
        *(u32x4*)(WT + (size_t)(drow0 + n) * ldk + koff + k0 + 8 * c) = o; }
    LDS_WAIT(); asm volatile("" ::: "memory");
}

struct Args { const float* in[21]; float* out; unsigned char* ws; unsigned long long cg_seams; };

__device__ __forceinline__ void p0_prologue(const Args& a, LAS unsigned char* lds, int tid, int lane, int wave, int G) {
    unsigned char* ws = a.ws;
    LAS float* scr = (LAS float*)(lds + wave * 16384);
    const int gw = blockIdx.x * 8 + wave, NGW = G * 8;
    constexpr int I1 = 16 * 176, I2 = 44 * 32, I3 = 16 * 152, I4 = 8 * 32, I6 = 16 * 32, I10 = 4 * 32;
    constexpr int NITEMS = I1 + I2 + I3 + I4 + I4 + I6 + I1 + I2 + I6 + I10;
    float* ss = (float*)(ws + WS_SS);
    bf16_t* HB = (bf16_t*)(ws + WS_HB);
    for (int pass = 0; pass < 2; ++pass) {
    if ((pass ^ (wave & 1)) == 0) {
    for (int it = gw; it < NITEMS; it += NGW) {
        int r = it;
        if (r < I1) { p0_transpose_item(a.in[5], 1024, 5632, (bf16_t*)(ws + WS_W1IN), a.in[4], 1, scr, r, lane); continue; } r -= I1;
        if (r < I2) { p0_transpose_item(a.in[6], 2816, 1024, (bf16_t*)(ws + WS_W1OUT), nullptr, 0, scr, r, lane); continue; } r -= I2;
        if (r < I3) { p0_transpose_item(a.in[8], 1024, 4864, (bf16_t*)(ws + WS_WIN), a.in[7], 2, scr, r, lane); continue; } r -= I3;
        if (r < I4) { p0_transpose_item(a.in[11], 512, 1024, (bf16_t*)(ws + WS_WATT), nullptr, 0, scr, r, lane, 1024, 0); continue; } r -= I4;
        if (r < I4) { p0_transpose_item(a.in[12], 512, 1024, (bf16_t*)(ws + WS_WATT), nullptr, 0, scr, r, lane, 1024, 512); continue; } r -= I4;
        if (r < I6) { p0_transpose_item(a.in[13], 1024, 1024, (bf16_t*)(ws + WS_WOUT), nullptr, 0, scr, r, lane); continue; } r -= I6;
        if (r < I1) { p0_transpose_item(a.in[15], 1024, 5632, (bf16_t*)(ws + WS_W2IN), a.in[14], 1, scr, r, lane); continue; } r -= I1;
        if (r < I2) { p0_transpose_item(a.in[16], 2816, 1024, (bf16_t*)(ws + WS_W2OUT), nullptr, 0, scr, r, lane); continue; } r -= I2;
        if (r < I6) { p0_transpose_item(a.in[18], 1024, 1024, (bf16_t*)(ws + WS_WG), a.in[17], 0, scr, r, lane); continue; } r -= I6;
        p0_transpose_item(a.in[19], 256, 1024, (bf16_t*)(ws + WS_WP), nullptr, 0, scr, r, lane);
    }
    } else {
    for (int m = gw; m < MTOK; m += 4 * NGW) {
        f32x4 v[4][4]; float s[4];
#pragma unroll
        for (int q = 0; q < 4; ++q) { const int mq = (m + q * NGW < MTOK) ? m + q * NGW : m; const f32x4* xr = (const f32x4*)(a.in[0] + (size_t)mq * DM) + lane;
#pragma unroll
            for (int j = 0; j < 4; ++j) v[q][j] = __builtin_nontemporal_load(xr + 64 * j); }
#pragma unroll
        for (int q = 0; q < 4; ++q) { s[q] = 0.f;
#pragma unroll
            for (int j = 0; j < 4; ++j) s[q] += (v[q][j].x * v[q][j].x + v[q][j].y * v[q][j].y) + (v[q][j].z * v[q][j].z + v[q][j].w * v[q][j].w); }
#pragma unroll
        for (int o = 1; o < 64; o <<= 1) {
#pragma unroll
            for (int q = 0; q < 4; ++q) s[q] += __shfl_xor(s[q], o); }
#pragma unroll
        for (int q = 0; q < 4; ++q) { const int mq = m + q * NGW;
            if (mq < MTOK) { u32x2* o8 = (u32x2*)(HB + (size_t)mq * DM) + lane;
#pragma unroll
                for (int j = 0; j < 4; ++j) { u32x2 w; w.x = pk2(v[q][j].x, v[q][j].y); w.y = pk2(v[q][j].z, v[q][j].w); o8[64 * j] = w; }
                if (lane == 0) *(f32x4*)(ss + (size_t)mq * 4) = (f32x4){s[q], 0.f, 0.f, 0.f}; } }
    }
    }
    }
    const int gt = blockIdx.x * 512 + tid, NGT = G * 512;
    bf16_t* PB = (bf16_t*)(ws + WS_PB);
    for (int i = gt; i < MTOK * PLE / 8; i += 4 * NGT) {
        f32x4 p0[4], p1[4];
#pragma unroll
        for (int q = 0; q < 4; ++q) { const int iq = (i + q * NGT < MTOK * PLE / 8) ? i + q * NGT : i; p0[q] = __builtin_nontemporal_load((const f32x4*)a.in[1] + 2 * iq); p1[q] = __builtin_nontemporal_load((const f32x4*)a.in[1] + 2 * iq + 1); }
#pragma unroll
        for (int q = 0; q < 4; ++q) { const int iq = i + q * NGT;
            if (iq < MTOK * PLE / 8) { u32x4 w; w.x = pk2(p0[q].x, p0[q].y); w.y = pk2(p0[q].z, p0[q].w); w.z = pk2(p1[q].x, p1[q].y); w.w = pk2(p1[q].z, p1[q].w); ((u32x4*)PB)[iq] = w; } }
    }
}


struct PartOrder {
    pg8::StaticOrder S; int pm0;
    __device__ void init(int Mpart, int N, int G, int c, int pm0_) { S.init(Mpart, N, G, c); pm0 = pm0_; }
    __device__ bool next(int i, pg8::Unit& u) const { const bool r = S.next(i, u); u.pm += pm0; return r; }
    __device__ __forceinline__ void a_ready(const pg8::Unit&) const {}
    __device__ __forceinline__ void done(const pg8::Unit&) const {}
};

struct RevOrder {
    pg8::StaticOrder S; int nr;
    __device__ void init(int M, int N, int G, int c) { S.init(M, N, G, c); nr = (S.nwg + G - 1) / G; }
    __device__ bool next(int i, pg8::Unit& u) const { if (i >= nr) return false; return S.next(nr - 1 - i, u); }
    __device__ __forceinline__ void a_ready(const pg8::Unit&) const {}
    __device__ __forceinline__ void done(const pg8::Unit&) const {}
};
#define XB_TMO      128
#define XB_XCNT(j)  (256  + 64 * (j))
#define XB_XSUB(j)  (1280 + 64 * (j))
#define XB_XGEN(j)  (2304 + 64 * (j))
#define XB_TOP      3328
#define XB_TOPGEN   3392
#define XCD_BAR_WORDS 3456
#define XB_SPIN_CAP (1u << 18)

__device__ __forceinline__ unsigned xb_ld(unsigned* p)              { return __hip_atomic_load(p, __ATOMIC_RELAXED, __HIP_MEMORY_SCOPE_AGENT); }
__device__ __forceinline__ unsigned xb_add(unsigned* p, unsigned v) { return __hip_atomic_fetch_add(p, v, __ATOMIC_RELAXED, __HIP_MEMORY_SCOPE_AGENT); }
__device__ __forceinline__ unsigned xb_xcc_id() { return (unsigned)__builtin_amdgcn_s_getreg((3 << 11) | 20) & 0xFu; }
#define XB_SPIN(cond, bar) do { unsigned _sp = 0; while (cond) { __builtin_amdgcn_s_sleep(1); \
    if ((++_sp & 255u) == 0u) { if (xb_ld(&(bar)[XB_TMO])) break; if (_sp > XB_SPIN_CAP) { atomicAdd(&(bar)[XB_TMO], 1u); break; } } } } while (0)

struct XcdBarrier {
    unsigned* bar; unsigned x;
    volatile LAS unsigned* st;
};

__device__ __forceinline__ XcdBarrier xcd_barrier_post(unsigned* bar, volatile LAS unsigned* st) {
    XcdBarrier b; b.bar = bar; b.x = xb_xcc_id(); b.st = st;
    if (threadIdx.x == 0) (void)xb_add(&bar[XB_XCNT(b.x)], 1u);
    return b;
}
__device__ __forceinline__ void xcd_barrier_complete(unsigned* bar, unsigned x, unsigned& nloc, unsigned& nx) {
    const unsigned G = gridDim.x * gridDim.y * gridDim.z;
    unsigned sum, cnt, mine, sp = 0u;
    for (;;) {
        sum = 0u; cnt = 0u; mine = 0u;
#pragma unroll
        for (unsigned j = 0; j < 16; ++j) { const unsigned c = xb_ld(&bar[XB_XCNT(j)]); sum += c; cnt += (c > 0u) ? 1u : 0u; mine = (j == x) ? c : mine; }
        if (sum == G) break;
        __builtin_amdgcn_s_sleep(1);
        if ((++sp & 255u) == 0u) { if (xb_ld(&bar[XB_TMO])) break; if (sp > XB_SPIN_CAP) { atomicAdd(&bar[XB_TMO], 1u); break; } }
    }
    nloc = mine > 0u ? mine : 1u; nx = cnt > 0u ? cnt : 1u;
}

__device__ __forceinline__ void xcd_barrier(const XcdBarrier& b) {
    asm volatile("s_waitcnt vmcnt(0)" ::: "memory");
    __syncthreads();
    if (threadIdx.x == 0) {
        unsigned* bar = b.bar;
        __builtin_amdgcn_s_waitcnt(0);
        unsigned nloc = b.st[0], nx = b.st[1];
        if (nloc == 0u) { xcd_barrier_complete(bar, b.x, nloc, nx); b.st[0] = nloc; b.st[1] = nx; }
        const unsigned old = xb_add(&bar[XB_XSUB(b.x)], 1u);
        const unsigned gen = old / nloc;
        if (old + 1u == (gen + 1u) * nloc) {
            __builtin_amdgcn_fence(__ATOMIC_RELEASE, "agent");
            asm volatile("s_waitcnt vmcnt(0)" ::: "memory");
            const unsigned og = xb_add(&bar[XB_TOP], 1u);
            const unsigned tg = og / nx;
            if (og + 1u == (tg + 1u) * nx) xb_add(&bar[XB_TOPGEN], 1u);
            else XB_SPIN(xb_ld(&bar[XB_TOPGEN]) == tg, bar);
            __builtin_amdgcn_fence(__ATOMIC_ACQUIRE, "agent");
            xb_add(&bar[XB_XGEN(b.x)], 1u);
            asm volatile("s_waitcnt vmcnt(0)" ::: "memory");
        } else {
            XB_SPIN(xb_ld(&bar[XB_XGEN(b.x)]) == gen, bar);
            __builtin_amdgcn_fence(__ATOMIC_ACQUIRE, "agent");
            asm volatile("s_waitcnt vmcnt(0)" ::: "memory");
        }
    }
    __syncthreads();
}

__device__ __forceinline__ void xcd_group_barrier(const XcdBarrier& b) {
    asm volatile("s_waitcnt vmcnt(0)" ::: "memory");
    __syncthreads();
    if (threadIdx.x == 0) {
        unsigned* bar = b.bar;
        __builtin_amdgcn_s_waitcnt(0);
        unsigned nloc = b.st[0], nx = b.st[1];
        if (nloc == 0u) { xcd_barrier_complete(bar, b.x, nloc, nx); b.st[0] = nloc; b.st[1] = nx; }
        const unsigned old = xb_add(&bar[XB_XSUB(b.x)], 1u);
        const unsigned gen = old / nloc;
        if (old + 1u == (gen + 1u) * nloc) xb_add(&bar[XB_XGEN(b.x)], 1u);
        else XB_SPIN(xb_ld(&bar[XB_XGEN(b.x)]) == gen, bar);
        __builtin_amdgcn_fence(__ATOMIC_ACQUIRE, "agent");
        asm volatile("s_waitcnt vmcnt(0)" ::: "memory");
    }
    __syncthreads();
}
typedef short bf16x8 __attribute__((ext_vector_type(8)));
typedef float f32x16 __attribute__((ext_vector_type(16)));
typedef float f32x2_t __attribute__((ext_vector_type(2)));
typedef __bf16 bf16x2_t __attribute__((ext_vector_type(2)));
__device__ __forceinline__ unsigned cvtpk_s(float lo, float hi) { f32x2_t v = {lo, hi}; bf16x2_t b = __builtin_convertvector(v, bf16x2_t); return __builtin_bit_cast(unsigned, b); }
__device__ __forceinline__ float ex(float x) { return __builtin_amdgcn_exp2f(x * 1.44269504f); }
#define LBAR() asm volatile("s_waitcnt lgkmcnt(0)\n\ts_barrier" ::: "memory")
#define MFMA32(a, b, c) __builtin_amdgcn_mfma_f32_32x32x16_bf16((a), (b), (c), 0, 0, 0)
__device__ __forceinline__ int crow(int r, int hi) { return (r & 3) + 8 * (r >> 2) + 4 * hi; }
__device__ __forceinline__ bf16x8 pack8(const f32x16& x, int s) {
    u32x4 p; p.x = cvtpk_s(x[8 * s], x[8 * s + 1]); p.y = cvtpk_s(x[8 * s + 2], x[8 * s + 3]); p.z = cvtpk_s(x[8 * s + 4], x[8 * s + 5]); p.w = cvtpk_s(x[8 * s + 6], x[8 * s + 7]);
    return __builtin_bit_cast(bf16x8, p);
}
__device__ __forceinline__ bf16x8 ld2x8(const LAS unsigned char* p) {
    const u32x2 lo = *(const LAS u32x2*)p, hi = *(const LAS u32x2*)(p + 16);
    u32x4 v; v.x = lo.x; v.y = lo.y; v.z = hi.x; v.w = hi.y; return __builtin_bit_cast(bf16x8, v);
}

__device__ __forceinline__ void attn_mfma_units(LAS unsigned char* lds, int u0, int ustride, int nunits, const bf16_t* Q, const bf16_t* Kb, const bf16_t* VT, const float* relb, const float* sinks, bf16_t* ATT, int tid) {
    constexpr int KP = 144, VP = 520;
    constexpr float LOG2E = 1.44269504f;
    LAS unsigned char* Ks = lds; LAS unsigned char* Vs = lds + 256 * KP; LAS float* ext = (LAS float*)(lds + 256 * KP + 64 * VP);
    const int lane = tid & 63, wv = tid >> 6, g = wv >> 1, l32 = lane & 31, hi = lane >> 5;
    const int skey = tid >> 1, shalf = tid & 1, sd = tid >> 3, sseg = tid & 7;
    u32x4 kw[4], vw[4];
#define AT_LOAD(u_) do { const int b_ = (u_) >> 5, n_ = ((u_) >> 1) & 15, hk_ = (u_) & 1; \
        const int kpos_ = n_ * 128 - 128 + skey, vpos_ = n_ * 128 - 128 + sseg * 32; \
        const u32x4* ks_ = (const u32x4*)(Kb + (size_t)(b_ * SEQL + (kpos_ < 0 ? 0 : kpos_)) * 128 + hk_ * 64 + shalf * 32); \
        const u32x4* vs_ = (const u32x4*)(VT + ((size_t)((b_ * 2 + hk_) * 64 + sd) << 11) + (vpos_ < 0 ? 0 : vpos_)); \
        _Pragma("unroll") for (int i = 0; i < 4; ++i) { kw[i] = ks_[i]; vw[i] = vs_[i]; } \
        if (kpos_ < 0) { _Pragma("unroll") for (int i = 0; i < 4; ++i) kw[i] = (u32x4){0u, 0u, 0u, 0u}; } \
        if (vpos_ < 0) { _Pragma("unroll") for (int i = 0; i < 4; ++i) vw[i] = (u32x4){0u, 0u, 0u, 0u}; } } while (0)
    if (u0 < nunits) AT_LOAD(u0);
    for (int unit = u0; unit < nunits; unit += ustride) {
        const int b = unit >> 5, n = (unit >> 1) & 15, hk = unit & 1, head = hk * 4 + g;
        {   LAS u32x4* d = (LAS u32x4*)(Ks + skey * KP + shalf * 64);
#pragma unroll
            for (int i = 0; i < 4; ++i) d[i] = kw[i];
            LAS u32x2* dd = (LAS u32x2*)(Vs + sd * VP + sseg * 64);
#pragma unroll
            for (int i = 0; i < 4; ++i) { u32x2 a; a.x = vw[i].x; a.y = vw[i].y; u32x2 c; c.x = vw[i].z; c.y = vw[i].w; dd[2 * i] = a; dd[2 * i + 1] = c; }
            for (int i = tid; i < 4 * 192; i += 512) { const int gg = i / 192, dist = i % 192 - 32;
                ext[i] = (dist >= 0 && dist < 128) ? relb[(int)T5_BUCKET[dist & 127] * 8 + hk * 4 + gg] * LOG2E : -INFINITY; }
        }
        bf16x8 qc[2][4];
#pragma unroll
        for (int sb = 0; sb < 2; ++sb) { const size_t row_ = (size_t)b * SEQL + n * 128 + 32 * (2 * (wv & 1) + sb) + l32;
#pragma unroll
            for (int ds = 0; ds < 4; ++ds) qc[sb][ds] = *(const bf16x8*)(Q + row_ * 512 + head * 64 + 16 * ds + 8 * hi); }
        LBAR();
        if (unit + ustride < nunits) AT_LOAD(unit + ustride);
        const float sink = sinks[head] * LOG2E;
        const LAS float* ex0 = ext + g * 192 + l32 - 4 * hi;
#pragma unroll
        for (int sb = 0; sb < 2; ++sb) {
            const int a = 2 * (wv & 1) + sb;
            const size_t row = (size_t)b * SEQL + n * 128 + 32 * a + l32;
            f32x16 S[5];
            {   bf16x8 kfr[2][4];
#pragma unroll
                for (int ds = 0; ds < 4; ++ds) kfr[0][ds] = *(const LAS bf16x8*)(Ks + (32 * a + l32) * KP + (16 * ds + 8 * hi) * 2);
#pragma unroll
                for (int t = 0; t < 5; ++t) {
                    if (t + 1 < 5) {
#pragma unroll
                        for (int ds = 0; ds < 4; ++ds) kfr[(t + 1) & 1][ds] = *(const LAS bf16x8*)(Ks + (32 * (a + t + 1) + l32) * KP + (16 * ds + 8 * hi) * 2);
                    }
                    f32x16 acc;
#pragma unroll
                    for (int r = 0; r < 16; ++r) acc[r] = 0.f;
#pragma unroll
                    for (int ds = 0; ds < 4; ++ds) acc = MFMA32(kfr[t & 1][ds], qc[sb][ds], acc);
                    S[t] = acc;
                }
            }
            float mx = sink;
#pragma unroll
            for (int t = 0; t < 5; ++t) {
                const bool dead = (n == 0) && (a + t < 4);
#pragma unroll
                for (int r = 0; r < 16; ++r) {
                    float sv = __builtin_fmaf(S[t][r], LOG2E, ex0[160 - 32 * t - (r & 3) - 8 * (r >> 2)]);
                    sv = dead ? -INFINITY : sv;
                    S[t][r] = sv; mx = fmaxf(mx, sv);
                }
            }
            mx = fmaxf(mx, __shfl_xor(mx, 32));
            float l = 0.f;
#pragma unroll
            for (int t = 0; t < 5; ++t)
#pragma unroll
                for (int r = 0; r < 16; ++r) { const float p = __builtin_amdgcn_exp2f(S[t][r] - mx); S[t][r] = p; l += p; }
            l += __shfl_xor(l, 32); l += __builtin_amdgcn_exp2f(sink - mx);
            f32x16 O[2];
#pragma unroll
            for (int dt = 0; dt < 2; ++dt)
#pragma unroll
                for (int r = 0; r < 16; ++r) O[dt][r] = 0.f;
            {   bf16x8 vfr[2][4];
#pragma unroll
                for (int i = 0; i < 4; ++i) vfr[0][i] = ld2x8(Vs + (l32 + 32 * (i & 1)) * VP + (32 * a + 16 * (i >> 1) + 4 * hi) * 2);
#pragma unroll
                for (int t = 0; t < 5; ++t) {
                    if (t + 1 < 5) {
#pragma unroll
                        for (int i = 0; i < 4; ++i) vfr[(t + 1) & 1][i] = ld2x8(Vs + (l32 + 32 * (i & 1)) * VP + (32 * (a + t + 1) + 16 * (i >> 1) + 4 * hi) * 2);
                    }
#pragma unroll
                    for (int kb = 0; kb < 2; ++kb) {
                        const bf16x8 pf = pack8(S[t], kb);
#pragma unroll
                        for (int dt = 0; dt < 2; ++dt) O[dt] = MFMA32(vfr[t & 1][2 * kb + dt], pf, O[dt]);
                    }
                }
            }
            const float rl = 1.0f / l;
#pragma unroll
            for (int dt = 0; dt < 2; ++dt)
#pragma unroll
                for (int c4 = 0; c4 < 4; ++c4) {
                    u32x2 w; w.x = cvtpk_s(O[dt][4 * c4] * rl, O[dt][4 * c4 + 1] * rl); w.y = cvtpk_s(O[dt][4 * c4 + 2] * rl, O[dt][4 * c4 + 3] * rl);
                    *(u32x2*)(ATT + row * 1024 + head * 64 + 32 * dt + 8 * c4 + 4 * hi) = w;
                }
            asm volatile("" ::: "memory");
        }
        LBAR();
    }
#undef AT_LOAD
}

__device__ __forceinline__ void rec_mfma_unit(LAS unsigned char* lds, int unit, const bf16_t* RQ, const bf16_t* RG, const bf16_t* RIT, const bf16_t* SG, const float* recnorm, bf16_t* REC, int tid) {
    constexpr int PQ = 272, PK = 144;
    LAS unsigned char* QT = lds;
    LAS unsigned char* KT = lds + 17408;
    LAS unsigned char* KH = lds + 34816;
    LAS unsigned char* VS = lds + 53248;
    LAS unsigned char* ST = lds + 71680;
    LAS float* GM = (LAS float*)(lds + 106496);
    LAS float* SEG = (LAS float*)(lds + 107008);
    LAS float* PSS = (LAS float*)(lds + 111104);
    LAS float* GN = (LAS float*)(lds + 129536);
    LAS unsigned char* OT = lds + 112128;
    const int b = unit >> 2, h = unit & 3;
    const int lane = tid & 63, wv = tid >> 6, l32 = lane & 31, hi = lane >> 5;
    const size_t R0 = (size_t)b * SEQL;
    const int cp = lane, tseg = wv;
    const bf16_t* gsrc = RG + (R0 + 8 * tseg) * 512 + h * 128 + 2 * cp;
    const bf16_t* qsrc = RQ + (R0 + 8 * tseg) * 512 + h * 128 + 2 * cp;
    const int vdv = tid >> 2, vpart = tid & 3;
    const bf16_t* vsrc = RIT + (((size_t)((b * 4 + h) * 128 + vdv)) << 11) + vpart * 16;
    const int dvi = wv >> 1, tj = ((wv >> 2) ^ wv) & 1;
    const int di = wv >> 1, dj0 = 2 * (wv & 1);
    const int trow = 32 * tj + l32;
    const int wt = tid >> 3, wp = tid & 7;
    const size_t woff = (R0 + wt) * 512 + h * 128 + wp * 16;
    const size_t roff = (R0 + wt) * 1024 + 512 + h * 128 + wp * 16;
    f32x16 SA[2];
#pragma unroll
    for (int x = 0; x < 2; ++x)
#pragma unroll
        for (int r = 0; r < 16; ++r) SA[x][r] = 0.f;
    if (tid < 128) GN[tid] = recnorm[tid];
    unsigned gw[8], qw[8]; u32x4 vw[2]; u32x4 sgw[2];
    sgw[0] = (u32x4){0u, 0u, 0u, 0u}; sgw[1] = sgw[0];
#pragma unroll
    for (int tt = 0; tt < 8; ++tt) { gw[tt] = *(const unsigned*)(gsrc + tt * 512); qw[tt] = *(const unsigned*)(qsrc + tt * 512); }
    vw[0] = *(const u32x4*)(vsrc); vw[1] = *(const u32x4*)(vsrc + 8);
#define REC_WRITEOUT(cc) do { const LAS u32x4* op_ = (const LAS u32x4*)(OT + wt * PQ + wp * 32); \
        _Pragma("unroll") for (int i_ = 0; i_ < 2; ++i_) { const u32x4 ov_ = op_[i_]; f32x4 a0_, a1_, s0_, s1_; \
            a0_ = (f32x4){bflo(ov_.x), bfhi(ov_.x), bflo(ov_.y), bfhi(ov_.y)}; a1_ = (f32x4){bflo(ov_.z), bfhi(ov_.z), bflo(ov_.w), bfhi(ov_.w)}; \
            s0_ = (f32x4){bflo(sgw[i_].x), bfhi(sgw[i_].x), bflo(sgw[i_].y), bfhi(sgw[i_].y)}; s1_ = (f32x4){bflo(sgw[i_].z), bfhi(sgw[i_].z), bflo(sgw[i_].w), bfhi(sgw[i_].w)}; \
            a0_ = a0_ * s0_; a1_ = a1_ * s1_; u32x4 w_; w_.x = cvtpk_s(a0_[0], a0_[1]); w_.y = cvtpk_s(a0_[2], a0_[3]); w_.z = cvtpk_s(a1_[0], a1_[1]); w_.w = cvtpk_s(a1_[2], a1_[3]); \
            *(u32x4*)(REC + roff + (size_t)(cc) * 64 * 1024 + 8 * i_) = w_; } } while (0)
    for (int c = 0; c < 32; ++c) {
        f32x2_t fv[8], cpv[8]; f32x2_t run = {1.f, 1.f};
#pragma unroll
        for (int tt = 0; tt < 8; ++tt) { fv[tt].x = ex(bflo(gw[tt])); fv[tt].y = ex(bfhi(gw[tt])); run = run * fv[tt]; cpv[tt] = run; }
        *(LAS f32x2_t*)(SEG + tseg * 128 + 2 * cp) = run;
        LBAR();
        if (c > 0) REC_WRITEOUT(c - 1);
        f32x2_t pre = {1.f, 1.f}, tot = {1.f, 1.f};
#pragma unroll
        for (int s = 0; s < 8; ++s) { const f32x2_t v = *(const LAS f32x2_t*)(SEG + s * 128 + 2 * cp); tot = tot * v; if (s < tseg) pre = pre * v; }
        f32x2_t kh[8];
#pragma unroll
        for (int tt = 0; tt < 8; ++tt) {
            const f32x2_t E = pre * cpv[tt];
            f32x2_t rE; rE.x = fminf(__builtin_amdgcn_rcpf(E.x), 5.5e34f); rE.y = fminf(__builtin_amdgcn_rcpf(E.y), 5.5e34f);
            const f32x2_t k = 1.0f - fv[tt];
            f32x2_t qv; qv.x = bflo(qw[tt]); qv.y = bfhi(qw[tt]);
            const f32x2_t qt = qv * E, kt = k * rE;
            kh[tt] = k * (tot * rE);
            *(LAS unsigned*)(QT + (8 * tseg + tt) * PQ + 4 * cp) = cvtpk_s(qt.x, qt.y);
            *(LAS unsigned*)(KT + (8 * tseg + tt) * PQ + 4 * cp) = cvtpk_s(kt.x, kt.y);
        }
        { u32x4 w0, w1; w0.x = cvtpk_s(kh[0].x, kh[1].x); w0.y = cvtpk_s(kh[2].x, kh[3].x); w0.z = cvtpk_s(kh[4].x, kh[5].x); w0.w = cvtpk_s(kh[6].x, kh[7].x);
          w1.x = cvtpk_s(kh[0].y, kh[1].y); w1.y = cvtpk_s(kh[2].y, kh[3].y); w1.z = cvtpk_s(kh[4].y, kh[5].y); w1.w = cvtpk_s(kh[6].y, kh[7].y);
          *(LAS u32x4*)(KH + (2 * cp) * PK + 16 * tseg) = w0; *(LAS u32x4*)(KH + (2 * cp + 1) * PK + 16 * tseg) = w1; }
        if (tseg == 0) *(LAS f32x2_t*)(GM + 2 * cp) = tot;
        *(LAS u32x4*)(VS + vdv * PK + vpart * 32) = vw[0]; *(LAS u32x4*)(VS + vdv * PK + vpart * 32 + 16) = vw[1];
        LBAR();
        if (c + 1 < 32) {
            const size_t adv = (size_t)(c + 1) * 64;
#pragma unroll
            for (int tt = 0; tt < 8; ++tt) { gw[tt] = *(const unsigned*)(gsrc + (adv + tt) * 512); qw[tt] = *(const unsigned*)(qsrc + (adv + tt) * 512); }
            vw[0] = *(const u32x4*)(vsrc + adv); vw[1] = *(const u32x4*)(vsrc + adv + 8);
        }
        sgw[0] = *(const u32x4*)(SG + woff + (size_t)c * 64 * 512); sgw[1] = *(const u32x4*)(SG + woff + (size_t)c * 64 * 512 + 8);
        bf16x8 qf[8], kf[8];
#pragma unroll
        for (int ks = 0; ks < 8; ++ks) qf[ks] = *(const LAS bf16x8*)(QT + trow * PQ + (16 * ks + 8 * hi) * 2);
#pragma unroll
        for (int ks = 0; ks < 8; ++ks) kf[ks] = *(const LAS bf16x8*)(KT + l32 * PQ + (16 * ks + 8 * hi) * 2);
        bf16x8 vf[2];
#pragma unroll
        for (int kb = 0; kb < 2; ++kb) vf[kb] = ld2x8(VS + (32 * dvi + l32) * PK + (16 * kb + 4 * hi) * 2);
        f32x16 at0, at1;
#pragma unroll
        for (int r = 0; r < 16; ++r) { at0[r] = 0.f; at1[r] = 0.f; }
#pragma unroll
        for (int ks = 0; ks < 8; ++ks) at0 = MFMA32(kf[ks], qf[ks], at0);
        if (tj) {
#pragma unroll
            for (int ks = 0; ks < 8; ++ks) kf[ks] = *(const LAS bf16x8*)(KT + (32 + l32) * PQ + (16 * ks + 8 * hi) * 2);
#pragma unroll
            for (int ks = 0; ks < 8; ++ks) at1 = MFMA32(kf[ks], qf[ks], at1);
#pragma unroll
            for (int r = 0; r < 16; ++r) at1[r] = (crow(r, hi) <= l32) ? at1[r] : 0.f;
        } else {
#pragma unroll
            for (int r = 0; r < 16; ++r) at0[r] = (crow(r, hi) <= l32) ? at0[r] : 0.f;
        }
        if (c > 0) {
#pragma unroll
            for (int ks = 0; ks < 8; ++ks) kf[ks] = *(const LAS bf16x8*)(ST + (32 * dvi + l32) * PQ + (16 * ks + 8 * hi) * 2);
        }
        f32x16 oacc;
#pragma unroll
        for (int r = 0; r < 16; ++r) oacc[r] = 0.f;
#pragma unroll
        for (int kb = 0; kb < 2; ++kb) { const bf16x8 pf = pack8(at0, kb); oacc = MFMA32(vf[kb], pf, oacc); }
        if (tj) {
            bf16x8 vg[2];
#pragma unroll
            for (int kb = 0; kb < 2; ++kb) vg[kb] = ld2x8(VS + (32 * dvi + l32) * PK + (32 + 16 * kb + 4 * hi) * 2);
#pragma unroll
            for (int kb = 0; kb < 2; ++kb) { const bf16x8 pf = pack8(at1, kb); oacc = MFMA32(vg[kb], pf, oacc); }
        }
        if (c > 0) {
#pragma unroll
            for (int ks = 0; ks < 8; ++ks) oacc = MFMA32(kf[ks], qf[ks], oacc);
        }
        { float ps = 0.f;
#pragma unroll
          for (int r = 0; r < 16; ++r) ps += oacc[r] * oacc[r];
          ps += __shfl_xor(ps, 32);
          if (hi == 0) PSS[dvi * 64 + trow] = ps; }
        LBAR();
        {   const float tot2 = (PSS[trow] + PSS[64 + trow]) + (PSS[128 + trow] + PSS[192 + trow]);
            const float rinv = __builtin_amdgcn_rsqf(tot2 * (1.0f / 128.0f) + 1e-6f);
#pragma unroll
            for (int c4 = 0; c4 < 4; ++c4) {
                const f32x4 gnv = *(const LAS f32x4*)(GN + 32 * dvi + 8 * c4 + 4 * hi);
                u32x2 w; w.x = cvtpk_s(oacc[4 * c4] * rinv * gnv[0], oacc[4 * c4 + 1] * rinv * gnv[1]); w.y = cvtpk_s(oacc[4 * c4 + 2] * rinv * gnv[2], oacc[4 * c4 + 3] * rinv * gnv[3]);
                *(LAS u32x2*)(OT + trow * PQ + (32 * dvi + 8 * c4 + 4 * hi) * 2) = w;
            }
        }
#pragma unroll
        for (int c4 = 0; c4 < 4; ++c4) { const f32x4 gm = *(const LAS f32x4*)(GM + 32 * di + 8 * c4 + 4 * hi);
#pragma unroll
            for (int x = 0; x < 2; ++x)
#pragma unroll
                for (int j = 0; j < 4; ++j) SA[x][4 * c4 + j] *= gm[j]; }
        { bf16x8 af[4], bv[2][4];
#pragma unroll
          for (int ks = 0; ks < 4; ++ks) { af[ks] = *(const LAS bf16x8*)(KH + (32 * di + l32) * PK + (16 * ks + 8 * hi) * 2);
#pragma unroll
              for (int x = 0; x < 2; ++x) bv[x][ks] = *(const LAS bf16x8*)(VS + (32 * (dj0 + x) + l32) * PK + (16 * ks + 8 * hi) * 2); }
#pragma unroll
          for (int ks = 0; ks < 4; ++ks)
#pragma unroll
              for (int x = 0; x < 2; ++x) SA[x] = MFMA32(af[ks], bv[x][ks], SA[x]); }
#pragma unroll
        for (int x = 0; x < 2; ++x)
#pragma unroll
            for (int c4 = 0; c4 < 4; ++c4) { u32x2 w; w.x = cvtpk_s(SA[x][4 * c4], SA[x][4 * c4 + 1]); w.y = cvtpk_s(SA[x][4 * c4 + 2], SA[x][4 * c4 + 3]);
                *(LAS u32x2*)(ST + (32 * (dj0 + x) + l32) * PQ + (32 * di + 8 * c4 + 4 * hi) * 2) = w; }
    }
    LBAR();
    REC_WRITEOUT(31);
    LBAR();
#undef REC_WRITEOUT
}

#define ATTN_UNIT attn_mfma_unit
#define REC_UNIT rec_mfma_unit
__global__ void __launch_bounds__(512, 2) fwd_megakernel(Args a) {
    extern __shared__ __attribute__((aligned(16))) unsigned char lds_raw[];
    LAS unsigned char* lds = (LAS unsigned char*)lds_raw;
    cg::grid_group grid = cg::this_grid();
    const int G = gridDim.x, bx = blockIdx.x;
#define FRESH_TID() int tid_ = threadIdx.x; asm volatile("" : "+v"(tid_)); const int tid = tid_, lane = tid & 63, wave = __builtin_amdgcn_readfirstlane(tid >> 6); (void)lane; (void)wave
    unsigned char* ws = a.ws;
    float* ss0 = (float*)(ws + WS_SS); float* ss1 = ss0 + 4 * MTOK; float* ss2 = ss1 + 4 * MTOK; float* ss3 = ss2 + 4 * MTOK; float* ss4 = ss3 + 4 * MTOK;
    bf16_t* HB = (bf16_t*)(ws + WS_HB); bf16_t* PB = (bf16_t*)(ws + WS_PB); bf16_t* ATT = (bf16_t*)(ws + WS_ATT); bf16_t* REC = (bf16_t*)(ws + WS_ATT);
    bf16_t* ACT = (bf16_t*)(ws + WS_ACT); bf16_t* MG = (bf16_t*)(ws + WS_MG); bf16_t* TPB = (bf16_t*)a.out;     bf16_t* H4B = (bf16_t*)(ws + WS_ATT);
    bf16_t* Qb = (bf16_t*)(ws + WS_Q); bf16_t* Kb = (bf16_t*)(ws + WS_K); bf16_t* VT = (bf16_t*)(ws + WS_VT); bf16_t* RQ = (bf16_t*)(ws + WS_RQ); bf16_t* RG = (bf16_t*)(ws + WS_RG);
    bf16_t* RIT = (bf16_t*)(ws + WS_RIT); bf16_t* SG = (bf16_t*)(ws + WS_SG); bf16_t* GA = (bf16_t*)(ws + WS_GA); bf16_t* GB = (bf16_t*)(ws + WS_GB);
    float* out = a.out;
    using pg8::Gemm; using pg8::StaticOrder; using pg8::gemm_phase;
    volatile LAS unsigned* MISC = (volatile LAS unsigned*)(lds + MISC_OFF);
    if (threadIdx.x < 32) MISC[threadIdx.x] = 0u;
    __syncthreads();
    const XcdBarrier xbar = xcd_barrier_post((unsigned*)(ws + WS_BAR), MISC + 8);

    { FRESH_TID(); p0_prologue(a, lds, tid, lane, wave, G); }
    if (a.cg_seams) grid.sync(); else xcd_barrier(xbar);

    { Gemm g{HB, (const bf16_t*)(ws + WS_W1IN), MTOK, 2 * DFF, DM}; StaticOrder S; S.init(MTOK, 2 * DFF, G, bx); pg8::EpiSwiglu E{ACT, ss0};
      gemm_phase<pg8::EpiSwiglu, StaticOrder, true, true>(lds, g, S, E); }
    xcd_barrier(xbar);
    { Gemm g{ACT, (const bf16_t*)(ws + WS_W1OUT), MTOK, DM, DFF}; StaticOrder S; S.init(MTOK, DM, G, bx); pg8::EpiRes<true> E{a.in[0], HB, ss1, 0.5f};
      gemm_phase<pg8::EpiRes<true>, StaticOrder, true, true>(lds, g, S, E); }
    xcd_barrier(xbar);
    { Gemm g{HB, (const bf16_t*)(ws + WS_WIN), MTOK, INW, DM}; StaticOrder S; S.init(MTOK, INW, G, bx); pg8::EpiWin E{ss1, a.in[3], Qb, Kb, VT, RQ, RG, RIT, SG, GA, GB};
      gemm_phase<pg8::EpiWin, StaticOrder, true, true>(lds, g, S, E); }
    xcd_barrier(xbar);
    {
        const int nrec = (G >= 256) ? 128 : G / 2;
        if (bx < nrec) { FRESH_TID(); for (int u = bx; u < NBATCH * 4; u += nrec) REC_UNIT(lds, u, RQ, RG, RIT, SG, a.in[10], REC, tid); }
        if (bx >= nrec) {
            const int na = G - nrec;
            { FRESH_TID();
            attn_mfma_units(lds, bx - nrec, na, NBATCH * 16 * 2, Qb, Kb, VT, a.in[2], a.in[9], ATT, tid); }
            Gemm g{PB, (const bf16_t*)(ws + WS_WP), MTOK, DM, PLE}; StaticOrder S; S.init(MTOK, DM, na, bx - nrec); pg8::EpiStoreBf16 E{TPB};
            gemm_phase<pg8::EpiStoreBf16, StaticOrder, true, true>(lds, g, S, E);
        }
    }
    xcd_barrier(xbar);
    { Gemm g{ATT, (const bf16_t*)(ws + WS_WATT), MTOK, DM, DM}; StaticOrder S; S.init(MTOK, DM, G, bx); pg8::EpiMerge E{GA, GB, MG};
      gemm_phase<pg8::EpiMerge, StaticOrder, true, true>(lds, g, S, E); }
    xcd_barrier(xbar);
    { Gemm g{MG, (const bf16_t*)(ws + WS_WOUT), MTOK, DM, DM}; StaticOrder S; S.init(MTOK, DM, G, bx); pg8::EpiRes<false> E{nullptr, HB, ss2, 1.0f};
      gemm_phase<pg8::EpiRes<false>, StaticOrder, true, true>(lds, g, S, E); }
    xcd_barrier(xbar);
    { Gemm g{HB, (const bf16_t*)(ws + WS_W2IN), MTOK, 2 * DFF, DM}; StaticOrder S; S.init(MTOK, 2 * DFF, G, bx); pg8::EpiSwiglu E{ACT, ss2};
      gemm_phase<pg8::EpiSwiglu, StaticOrder, true, true>(lds, g, S, E); }
    xcd_barrier(xbar);
    { Gemm g{ACT, (const bf16_t*)(ws + WS_W2OUT), MTOK, DM, DFF}; StaticOrder S; S.init(MTOK, DM, G, bx); pg8::EpiRes<false> E{nullptr, HB, ss3, 0.5f};
      gemm_phase<pg8::EpiRes<false>, StaticOrder, true, true>(lds, g, S, E); }
    xcd_barrier(xbar);
    { Gemm g{HB, (const bf16_t*)(ws + WS_WG), MTOK, DM, DM}; StaticOrder S; S.init(MTOK, DM, G, bx); pg8::EpiPle2 E{ss3, TPB, HB, H4B, ss4};
      gemm_phase<pg8::EpiPle2, StaticOrder, true, true>(lds, g, S, E); }
    xcd_barrier(xbar);
    {
        FRESH_TID();
        const int gw = bx * 8 + wave, NGW = G * 8;
        const f32x4* gf = (const f32x4*)a.in[20] + lane;
        f32x4 gv[4];
#pragma unroll
        for (int j = 0; j < 4; ++j) gv[j] = gf[64 * j];
        for (int m = gw; m < MTOK; m += 4 * NGW) {
            u32x2 w[4][4]; float rin[4];
#pragma unroll
            for (int q = 0; q < 4; ++q) { const int mq = (m + q * NGW < MTOK) ? m + q * NGW : m; const u32x2* hr = (const u32x2*)(H4B + (size_t)mq * DM) + lane;
                { const f32x4 q4 = *(const f32x4*)(ss4 + (size_t)mq * 4); rin[q] = (q4[0] + q4[1]) + (q4[2] + q4[3]); }
#pragma unroll
                for (int j = 0; j < 4; ++j) w[q][j] = __builtin_nontemporal_load(hr + 64 * j); }
#pragma unroll
            for (int q = 0; q < 4; ++q) { const int mq = m + q * NGW;
                if (mq < MTOK) { const float rinv = __builtin_amdgcn_rsqf(rin[q] * (1.0f / 1024.0f) + 1e-6f); f32x4* xr = (f32x4*)(out + (size_t)mq * DM) + lane;
#pragma unroll
                    for (int j = 0; j < 4; ++j) { f32x4 v = (f32x4){bflo(w[q][j].x), bfhi(w[q][j].x), bflo(w[q][j].y), bfhi(w[q][j].y)}; v = v * rinv * gv[j]; __builtin_nontemporal_store(v, xr + 64 * j); } } }
        }
    }
}

extern "C" void kernel_launch(void* const* d_in, const int* in_sizes, int n_in, void* d_out, int out_size, void* d_ws, size_t ws_size, hipStream_t stream) {
    static int grid = 0;
    if (grid == 0) {
        int dev = 0, cus = 0, per_cu = 0;
        (void)hipGetDevice(&dev);
        (void)hipDeviceGetAttribute(&cus, hipDeviceAttributeMultiprocessorCount, dev);
        (void)hipFuncSetAttribute((const void*)fwd_megakernel, hipFuncAttributeMaxDynamicSharedMemorySize, LDS_BYTES);
        if (hipOccupancyMaxActiveBlocksPerMultiprocessor(&per_cu, (const void*)fwd_megakernel, 512, LDS_BYTES) != hipSuccess || per_cu < 1) per_cu = 1;
        (void)hipGetLastError();
        if (cus <= 0) cus = 256;
        grid = cus * per_cu;
    }
    (void)hipMemsetAsync((unsigned char*)d_ws + WS_BAR, 0, XCD_BAR_WORDS * 4, stream);
    Args a{};
    for (int i = 0; i < 21; ++i) a.in[i] = (const float*)d_in[i];
    a.out = (float*)d_out; a.ws = (unsigned char*)d_ws;
    void* args[] = {&a};
    hipError_t e = hipLaunchCooperativeKernel((const void*)fwd_megakernel, dim3(grid), dim3(512), args, LDS_BYTES, stream);
    if (e != hipSuccess) fprintf(stderr, "cooperative launch failed: %s (grid %d)\n", hipGetErrorString(e), grid);
}
```
